# Optimizing an MI355X kernel written in HIP

```python
import math
import jax
import jax.numpy as jnp
from jax import lax
import numpy as np


D_MODEL = 2048
BATCH = 16
SEQ = 2048
DEPTH = 4

GRID_W = 64
CTX_LEN = 256
HEAD_DIM = 64
N_BRANCH = 4
MIX_W = D_MODEL // N_BRANCH
NA_HEADS = MIX_W // HEAD_DIM
NA_ROWS = 8
NA_COLS = 16
DIFF_HEADS = MIX_W // (2 * HEAD_DIM)
DIFF_V_DIM = 2 * HEAD_DIM
SWA_HEADS = MIX_W // HEAD_DIM
SWA_KV_HEADS = 2
SWA_GROUP = SWA_HEADS // SWA_KV_HEADS
SWA_WINDOW = 128
POOL_WINDOWS = (2, 4, 8, 16)
POOL_GROUP_W = MIX_W // len(POOL_WINDOWS)
D_FF = -(-(8 * D_MODEL) // (3 * 256)) * 256
Q_BLOCK = 128
ROPE_BASE = 10000.0
NORM_EPS = 1e-6
MASK_VALUE = -1e30
ATTN_SCALE = HEAD_DIM ** -0.5
PROJ_SIZES = (MIX_W, MIX_W, MIX_W, MIX_W, MIX_W, MIX_W, MIX_W, SWA_KV_HEADS * HEAD_DIM, SWA_KV_HEADS * HEAD_DIM, MIX_W, N_BRANCH * D_MODEL)
PROJ_W = sum(PROJ_SIZES)

kernel_name = 'hybrid_dit_prefix_block'


def rmsnorm(x, g):
    xf = x.astype(jnp.float32)
    y = xf * lax.rsqrt(jnp.mean(xf * xf, axis=-1, keepdims=True) + NORM_EPS)
    return (y * g.astype(jnp.float32)).astype(x.dtype)


def modulate(x, shift, scale):
    return x * (1 + scale) + shift


def split_heads(t, shape):
    return t.reshape(t.shape[:-1] + shape)


def split_cols(t):
    offsets = []
    acc = 0
    for s in PROJ_SIZES[:-1]:
        acc += s
        offsets.append(acc)
    return jnp.split(t, offsets, axis=-1)


def rope_tables(seq):
    t = jnp.arange(seq)
    pos = jnp.stack([t // GRID_W, t % GRID_W], axis=-1).astype(jnp.float32)
    n_freq = HEAD_DIM // 4
    inv = ROPE_BASE ** (-jnp.arange(n_freq, dtype=jnp.float32) / n_freq)
    ang = pos[:, :, None] * inv
    return jnp.cos(ang), jnp.sin(ang)


def rope2d(x, cos, sin):
    n_mid = x.ndim - 3
    cs_shape = (cos.shape[0],) + (1,) * n_mid + cos.shape[1:]
    cos = cos.reshape(cs_shape).astype(x.dtype)
    sin = sin.reshape(cs_shape).astype(x.dtype)
    xs = x.reshape(x.shape[:-1] + (2, 2, HEAD_DIM // 4))
    x0, x1 = xs[..., 0, :], xs[..., 1, :]
    out = jnp.stack([x0 * cos - x1 * sin, x1 * cos + x0 * sin], axis=-2)
    return out.reshape(x.shape)


def neighbourhood_attention(q, k, v, kc, vc, rpb):
    B_, S, H, dh = q.shape
    rows = S // GRID_W
    kr = min(NA_ROWS, rows)
    r = jnp.arange(rows)
    row_idx = jnp.clip(r - kr // 2, 0, rows - kr)[:, None] + jnp.arange(kr)[None, :]
    dr = row_idx - r[:, None] + (NA_ROWS - 1)
    col = jnp.arange(GRID_W)
    col_start = jnp.clip(col - NA_COLS // 2, 0, GRID_W - NA_COLS)
    col_mask = (col[None, :] >= col_start[:, None]) & (col[None, :] < col_start[:, None] + NA_COLS)
    dc = jnp.clip(col[None, :] - col[:, None], -(NA_COLS - 1), NA_COLS - 1) + (NA_COLS - 1)
    bias = rpb[:, dr[:, None, :, None], dc[None, :, None, :]]
    qg = q.reshape(B_, rows, GRID_W, H, dh)
    kg = k.reshape(B_, rows, GRID_W, H, dh)[:, row_idx]
    vg = v.reshape(B_, rows, GRID_W, H, dh)[:, row_idx]
    s = jnp.einsum('brqhd,brkwhd->bhrqkw', qg, kg).astype(jnp.float32) * ATTN_SCALE + bias[None].astype(jnp.float32)
    s = jnp.where(col_mask[:, None, :], s, MASK_VALUE)
    n_lat = kr * GRID_W
    s = s.reshape(B_, H, rows, GRID_W, n_lat)
    sc = jnp.einsum('brqhd,bchd->bhrqc', qg, kc).astype(jnp.float32) * ATTN_SCALE
    p = jax.nn.softmax(jnp.concatenate([s, sc], axis=-1), axis=-1).astype(v.dtype)
    p_lat = p[..., :n_lat].reshape(B_, H, rows, GRID_W, kr, GRID_W)
    o = jnp.einsum('bhrqkw,brkwhd->brqhd', p_lat, vg) + jnp.einsum('bhrqc,bchd->brqhd', p[..., n_lat:], vc)
    return o.reshape(B_, S, H * dh)


def diff_attention_latent(q, k, v, kc, vc, lam):
    B_, S = q.shape[:2]
    nb = S // Q_BLOCK
    qb = jnp.moveaxis(q.reshape((B_, nb, Q_BLOCK) + q.shape[2:]), 1, 0)

    def block(qblk):
        s = jnp.einsum('bqhid,bkhid->bhiqk', qblk, k)
        sc = jnp.einsum('bqhid,bchid->bhiqc', qblk, kc)
        p = jax.nn.softmax(jnp.concatenate([s, sc], axis=-1).astype(jnp.float32) * ATTN_SCALE, axis=-1)
        a = (p[:, :, 0] - lam * p[:, :, 1]).astype(v.dtype)
        return jnp.einsum('bhqk,bkhe->bqhe', a[..., :S], v) + jnp.einsum('bhqc,bche->bqhe', a[..., S:], vc)

    o = lax.map(block, qb)
    return jnp.moveaxis(o, 0, 1).reshape((B_, S) + v.shape[2:])


def diff_attention_ctx(q, k, v, lam):
    s = jnp.einsum('bqhid,bkhid->bhiqk', q, k).astype(jnp.float32) * ATTN_SCALE
    p = jax.nn.softmax(s, axis=-1)
    a = (p[:, :, 0] - lam * p[:, :, 1]).astype(v.dtype)
    return jnp.einsum('bhqk,bkhe->bqhe', a, v)


def diff_output(o, g, lam_init):
    return (rmsnorm(o, g) * (1.0 - lam_init)).reshape(o.shape[:2] + (-1,))


def window_attention(q, k, v, kc, vc, sink):
    B_, S = q.shape[:2]
    W = SWA_WINDOW
    nb = S // W

    def bands(t):
        tp = jnp.pad(t, ((0, 0), (W, W), (0, 0), (0, 0))).reshape((B_, nb + 2, W) + t.shape[2:])
        return jnp.concatenate([tp[:, :-2], tp[:, 1:-1], tp[:, 2:]], axis=2)

    kb, vb = bands(k), bands(v)
    qb = q.reshape((B_, nb, W) + q.shape[2:])
    i = jnp.arange(W)
    j = jnp.arange(3 * W)
    n = jnp.arange(nb)
    rel = j[None, :] - W - i[:, None]
    kpos = n[:, None] * W - W + j[None, :]
    valid = (jnp.abs(rel) <= W)[None] & ((kpos >= 0) & (kpos < S))[:, None, :]
    s = jnp.einsum('bnqkgd,bnjkd->bnkgqj', qb, kb).astype(jnp.float32) * ATTN_SCALE
    s = jnp.where(valid[None, :, None, None], s, MASK_VALUE)
    sc = jnp.einsum('bnqkgd,bckd->bnkgqc', qb, kc).astype(jnp.float32) * ATTN_SCALE
    snk = jnp.broadcast_to(sink.astype(jnp.float32)[None, None, :, :, None, None], s.shape[:-1] + (1,))
    p = jax.nn.softmax(jnp.concatenate([s, sc, snk], axis=-1), axis=-1).astype(v.dtype)
    n_lat = 3 * W
    n_ctx = kc.shape[1]
    o = jnp.einsum('bnkgqj,bnjkd->bnqkgd', p[..., :n_lat], vb) + jnp.einsum('bnkgqc,bckd->bnqkgd', p[..., n_lat:n_lat + n_ctx], vc)
    return o.reshape(B_, S, -1)


def ctx_attention(q, k, v, sink=None):
    B_, L = q.shape[:2]
    s = jnp.einsum('bqkgd,bckd->bkgqc', q, k).astype(jnp.float32) * ATTN_SCALE
    if sink is not None:
        snk = jnp.broadcast_to(sink.astype(jnp.float32)[None, :, :, None, None], s.shape[:-1] + (1,))
        s = jnp.concatenate([s, snk], axis=-1)
    p = jax.nn.softmax(s, axis=-1)[..., :L].astype(v.dtype)
    o = jnp.einsum('bkgqc,bckd->bqkgd', p, v)
    return o.reshape(B_, L, -1)


def pool_mixer(u, w_grp, scale):
    B_, T, _ = u.shape
    ug = u.reshape(B_, T, len(POOL_WINDOWS), POOL_GROUP_W).astype(jnp.float32)
    cs = jnp.concatenate([jnp.zeros_like(ug[:, :1]), jnp.cumsum(ug, axis=1)], axis=1)
    t = jnp.arange(T)
    means = []
    for g, w in enumerate(POOL_WINDOWS):
        lo = jnp.clip(t - w // 2, 0, T)
        hi = jnp.clip(t - w // 2 + w, 0, T)
        cnt = (hi - lo).astype(jnp.float32)[None, :, None]
        means.append((cs[:, hi, g] - cs[:, lo, g]) / cnt)
    pooled = jnp.stack(means, axis=2)
    d = (pooled - ug).astype(u.dtype)
    mixed = jnp.einsum('btgc,gce->btge', d, w_grp)
    return mixed.reshape(B_, T, MIX_W) * scale


def merge_branches(outs, gate_logits, w_br, w_o):
    B_, T = gate_logits.shape[:2]
    gates = jax.nn.sigmoid(gate_logits).reshape(B_, T, N_BRANCH, D_MODEL)
    acc = gates[:, :, 0] * (outs[0] @ w_br[0])
    for n in range(1, N_BRANCH):
        acc = acc + gates[:, :, n] * (outs[n] @ w_br[n])
    return acc @ w_o


def swiglu(h, wg, wu, wd):
    return (jax.nn.silu(h @ wg) * (h @ wu)) @ wd


def setup_inputs(seed: int = 0) -> dict:
    key = jax.random.key(seed)
    ks = jax.random.split(key, 32)
    f32 = jnp.float32
    L = DEPTH
    D = D_MODEL

    def nrm(k, shape, scale):
        return jax.random.normal(k, shape, f32) * scale

    return {
        'x': nrm(ks[0], (BATCH, SEQ, D), 1.0),
        'c': nrm(ks[1], (BATCH, D), 1.0),
        'ctx': nrm(ks[2], (BATCH, CTX_LEN, D), 1.0),
        'c_ctx': nrm(ks[3], (D,), 1.0),
        'w_ada': nrm(ks[4], (L, D, 6 * D), 0.5 * D ** -0.5),
        'b_ada': nrm(ks[5], (L, 6 * D), 0.02),
        'norm_mix': 1.0 + nrm(ks[6], (L, D), 0.02),
        'norm_ffn': 1.0 + nrm(ks[7], (L, D), 0.02),
        'w_in': nrm(ks[8], (L, D, PROJ_W), D ** -0.5),
        'a_q_norm': 1.0 + nrm(ks[9], (L, HEAD_DIM), 0.02),
        'a_k_norm': 1.0 + nrm(ks[10], (L, HEAD_DIM), 0.02),
        'a_rpb': nrm(ks[11], (L, NA_HEADS, 2 * NA_ROWS - 1, 2 * NA_COLS - 1), 0.1),
        'b_q_norm': 1.0 + nrm(ks[12], (L, HEAD_DIM), 0.02),
        'b_k_norm': 1.0 + nrm(ks[13], (L, HEAD_DIM), 0.02),
        'b_lam_q1': nrm(ks[14], (L, HEAD_DIM), 0.1),
        'b_lam_k1': nrm(ks[15], (L, HEAD_DIM), 0.1),
        'b_lam_q2': nrm(ks[16], (L, HEAD_DIM), 0.1),
        'b_lam_k2': nrm(ks[17], (L, HEAD_DIM), 0.1),
        'b_subln': 1.0 + nrm(ks[18], (L, DIFF_V_DIM), 0.02),
        'c_q_norm': 1.0 + nrm(ks[19], (L, HEAD_DIM), 0.02),
        'c_k_norm': 1.0 + nrm(ks[20], (L, HEAD_DIM), 0.02),
        'c_sink': nrm(ks[21], (L, SWA_HEADS), 0.5),
        'd_w': nrm(ks[22], (L, len(POOL_WINDOWS), POOL_GROUP_W, POOL_GROUP_W), POOL_GROUP_W ** -0.5),
        'd_scale': 1.0 + nrm(ks[23], (L, MIX_W), 0.1),
        'w_branch': nrm(ks[24], (L, N_BRANCH, MIX_W, D), MIX_W ** -0.5),
        'w_out': nrm(ks[25], (L, D, D), D ** -0.5),
        'w_ffn_gate': nrm(ks[26], (L, D, D_FF), D ** -0.5),
        'w_ffn_up': nrm(ks[27], (L, D, D_FF), D ** -0.5),
        'w_ffn_down': nrm(ks[28], (L, D_FF, D), D_FF ** -0.5),
    }


def reference(x, c, ctx, c_ctx, w_ada, b_ada, norm_mix, norm_ffn, w_in, a_q_norm, a_k_norm, a_rpb, b_q_norm, b_k_norm, b_lam_q1, b_lam_k1, b_lam_q2, b_lam_k2, b_subln, c_q_norm, c_k_norm, c_sink, d_w, d_scale, w_branch, w_out, w_ffn_gate, w_ffn_up, w_ffn_down):
    D = x.shape[-1]
    cos, sin = rope_tables(x.shape[1])
    c_act = jax.nn.silu(c)
    cctx_act = jax.nn.silu(c_ctx)
    for l in range(DEPTH):
        last = l == DEPTH - 1
        mod = c_act @ w_ada[l] + b_ada[l]
        sh_mix, sc_mix, g_mix, sh_ffn, sc_ffn, g_ffn = [m[:, None, :] for m in jnp.split(mod, 6, axis=-1)]
        n_ctx_mod = 2 if last else 6
        mod_c = jnp.split(cctx_act @ w_ada[l, :, :n_ctx_mod * D] + b_ada[l, :n_ctx_mod * D], n_ctx_mod, axis=-1)

        h = modulate(rmsnorm(x, norm_mix[l]), sh_mix, sc_mix)
        hc = modulate(rmsnorm(ctx, norm_mix[l]), mod_c[0], mod_c[1])
        aq, ak, av, bq, bk, bv, sq, sk, sv, du, gl = split_cols(h @ w_in[l])
        if last:
            wp = split_cols(w_in[l])
            akc, avc, bkc, bvc, skc, svc = [hc @ wp[i] for i in (1, 2, 4, 5, 7, 8)]
        else:
            aqc, akc, avc, bqc, bkc, bvc, sqc, skc, svc, duc, glc = split_cols(hc @ w_in[l])

        lam_init = 0.8 - 0.6 * math.exp(-0.3 * l)
        lam = (jnp.exp(jnp.sum(b_lam_q1[l].astype(jnp.float32) * b_lam_k1[l].astype(jnp.float32)))
               - jnp.exp(jnp.sum(b_lam_q2[l].astype(jnp.float32) * b_lam_k2[l].astype(jnp.float32))) + lam_init)
        sink = c_sink[l].reshape(SWA_KV_HEADS, SWA_GROUP)

        ka_c = rmsnorm(split_heads(akc, (NA_HEADS, HEAD_DIM)), a_k_norm[l])
        va_c = split_heads(avc, (NA_HEADS, HEAD_DIM))
        kb_c = rmsnorm(split_heads(bkc, (DIFF_HEADS, 2, HEAD_DIM)), b_k_norm[l])
        vb_c = split_heads(bvc, (DIFF_HEADS, DIFF_V_DIM))
        ks_c = rmsnorm(split_heads(skc, (SWA_KV_HEADS, HEAD_DIM)), c_k_norm[l])
        vs_c = split_heads(svc, (SWA_KV_HEADS, HEAD_DIM))

        o_a = neighbourhood_attention(
            rmsnorm(split_heads(aq, (NA_HEADS, HEAD_DIM)), a_q_norm[l]),
            rmsnorm(split_heads(ak, (NA_HEADS, HEAD_DIM)), a_k_norm[l]),
            split_heads(av, (NA_HEADS, HEAD_DIM)), ka_c, va_c, a_rpb[l])
        o_b = diff_output(diff_attention_latent(
            rope2d(rmsnorm(split_heads(bq, (DIFF_HEADS, 2, HEAD_DIM)), b_q_norm[l]), cos, sin),
            rope2d(rmsnorm(split_heads(bk, (DIFF_HEADS, 2, HEAD_DIM)), b_k_norm[l]), cos, sin),
            split_heads(bv, (DIFF_HEADS, DIFF_V_DIM)), kb_c, vb_c, lam), b_subln[l], lam_init)
        o_s = window_attention(
            rope2d(rmsnorm(split_heads(sq, (SWA_KV_HEADS, SWA_GROUP, HEAD_DIM)), c_q_norm[l]), cos, sin),
            rope2d(rmsnorm(split_heads(sk, (SWA_KV_HEADS, HEAD_DIM)), c_k_norm[l]), cos, sin),
            split_heads(sv, (SWA_KV_HEADS, HEAD_DIM)), ks_c, vs_c, sink)
        o_d = pool_mixer(du, d_w[l], d_scale[l])
        x = x + g_mix * merge_branches((o_a, o_b, o_s, o_d), gl, w_branch[l], w_out[l])

        if not last:
            oc_a = ctx_attention(rmsnorm(split_heads(aqc, (NA_HEADS, 1, HEAD_DIM)), a_q_norm[l]), ka_c, va_c)
            oc_b = diff_output(diff_attention_ctx(
                rmsnorm(split_heads(bqc, (DIFF_HEADS, 2, HEAD_DIM)), b_q_norm[l]), kb_c, vb_c, lam), b_subln[l], lam_init)
            oc_s = ctx_attention(rmsnorm(split_heads(sqc, (SWA_KV_HEADS, SWA_GROUP, HEAD_DIM)), c_q_norm[l]), ks_c, vs_c, sink)
            oc_d = pool_mixer(duc, d_w[l], d_scale[l])
            ctx = ctx + mod_c[2] * merge_branches((oc_a, oc_b, oc_s, oc_d), glc, w_branch[l], w_out[l])
            ctx = ctx + mod_c[5] * swiglu(modulate(rmsnorm(ctx, norm_ffn[l]), mod_c[3], mod_c[4]),
                                          w_ffn_gate[l], w_ffn_up[l], w_ffn_down[l])

        x = x + g_ffn * swiglu(modulate(rmsnorm(x, norm_ffn[l]), sh_ffn, sc_ffn),
                               w_ffn_gate[l], w_ffn_up[l], w_ffn_down[l])
    return x
```

```cpp
#ifndef HOST_EMU
#include <hip/hip_runtime.h>
#endif
#include <cstdio>
#include <cstdint>
#include <cmath>
#include <cstring>

#ifndef CFG_D
#define CFG_D 2048
#endif
#ifndef CFG_B
#define CFG_B 16
#endif
#ifndef CFG_S
#define CFG_S 2048
#endif
#ifndef CFG_L
#define CFG_L 4
#endif
#ifndef CFG_CL
#define CFG_CL 256
#endif
constexpr int D = CFG_D, NB = CFG_B, S = CFG_S, NL = CFG_L, CL = CFG_CL;
constexpr int GW = 64, HDIM = 64, MIXW = D / 4, NAH = MIXW / 64, DFH = MIXW / 128, SWH = MIXW / 64, SKV = 2, SG = SWH / SKV;
constexpr int PGW = MIXW / 4, DFF = ((8 * D + 767) / 768) * 256, ROWS = S / GW, NAR = 8, NAC = 16, SWW = 128;
constexpr int C_AQ = 0, C_AK = MIXW, C_AV = 2 * MIXW, C_BQ = 3 * MIXW, C_BK = 4 * MIXW, C_BV = 5 * MIXW, C_SQ = 6 * MIXW, C_SK = 7 * MIXW, C_SV = 7 * MIXW + SKV * HDIM, C_DU = 7 * MIXW + 2 * SKV * HDIM;
constexpr int NQKV = C_DU + MIXW, NGATE = 4 * D, PROJW = NQKV + NGATE;
constexpr int M_LAT = NB * S, M_CTX = NB * CL, MT = M_LAT + M_CTX;
constexpr int NSLOT = 2 * NAH + 4 * DFH + SWH + SKV;
constexpr float NORM_EPS = 1e-6f;
static_assert(ROWS >= NAR && ROWS <= 64, "grid rows");

#ifdef HOST_EMU
#define HDF inline
#define FEXP(x) expf(x)
#else
#define HDF __device__ __forceinline__
#define FEXP(x) __expf(x)
#endif

typedef unsigned short bf16;
struct alignas(16) U4 { unsigned x, y, z, w; };
struct alignas(8) F2 { float x, y; };

HDF float bf2f(bf16 h) { unsigned u = (unsigned)h << 16; float f; memcpy(&f, &u, 4); return f; }
HDF float bflo(unsigned u) { unsigned v = u << 16; float f; memcpy(&f, &v, 4); return f; }
HDF float bfhi(unsigned u) { unsigned v = u & 0xffff0000u; float f; memcpy(&f, &v, 4); return f; }
HDF unsigned f2bf(float f) { unsigned u; memcpy(&u, &f, 4); return (u + 0x7fffu + ((u >> 16) & 1u)) >> 16; }
HDF unsigned pk2(float lo, float hi) { return f2bf(lo) | (f2bf(hi) << 16); }

struct LayerP { const float *aqn, *akn, *rpb, *bqn, *bkn, *subln, *cqn, *ckn, *sink, *dw, *dscale; };

HDF void row_decode(int m, bool& isctx, int& b, int& t) {
    isctx = m >= M_LAT;
    if (!isctx) { b = m / S; t = m - b * S; } else { const int r = m - M_LAT; b = r / CL; t = r - b * CL; }
}

HDF void load64(const bf16* p, float (&x)[64]) {
#pragma unroll
    for (int i = 0; i < 8; ++i) { const U4 v = *(const U4*)(p + 8 * i);
        x[8 * i + 0] = bflo(v.x); x[8 * i + 1] = bfhi(v.x); x[8 * i + 2] = bflo(v.y); x[8 * i + 3] = bfhi(v.y);
        x[8 * i + 4] = bflo(v.z); x[8 * i + 5] = bfhi(v.z); x[8 * i + 6] = bflo(v.w); x[8 * i + 7] = bfhi(v.w); }
}
HDF float dot64(const float (&q)[64], const bf16* p) {
    float s0 = 0.f, s1 = 0.f;
#pragma unroll
    for (int i = 0; i < 8; ++i) { const U4 v = *(const U4*)(p + 8 * i);
        s0 += q[8 * i + 0] * bflo(v.x); s1 += q[8 * i + 1] * bfhi(v.x); s0 += q[8 * i + 2] * bflo(v.y); s1 += q[8 * i + 3] * bfhi(v.y);
        s0 += q[8 * i + 4] * bflo(v.z); s1 += q[8 * i + 5] * bfhi(v.z); s0 += q[8 * i + 6] * bflo(v.w); s1 += q[8 * i + 7] * bfhi(v.w); }
    return s0 + s1;
}
HDF void osm_step(float s, const bf16* vrow, float& mx, float& l, float (&acc)[64]) {
    if (s > mx) { const float c = FEXP(mx - s); l *= c;
#pragma unroll
        for (int d = 0; d < 64; ++d) acc[d] *= c;
        mx = s; }
    const float p = FEXP(s - mx); l += p;
#pragma unroll
    for (int i = 0; i < 8; ++i) { const U4 v = *(const U4*)(vrow + 8 * i);
        acc[8 * i + 0] += p * bflo(v.x); acc[8 * i + 1] += p * bfhi(v.x); acc[8 * i + 2] += p * bflo(v.y); acc[8 * i + 3] += p * bfhi(v.y);
        acc[8 * i + 4] += p * bflo(v.z); acc[8 * i + 5] += p * bfhi(v.z); acc[8 * i + 6] += p * bflo(v.w); acc[8 * i + 7] += p * bfhi(v.w); }
}
HDF void store64(bf16* p, const float (&a)[64], float sc) {
#pragma unroll
    for (int i = 0; i < 8; ++i) { U4 v; v.x = pk2(a[8 * i] * sc, a[8 * i + 1] * sc); v.y = pk2(a[8 * i + 2] * sc, a[8 * i + 3] * sc);
        v.z = pk2(a[8 * i + 4] * sc, a[8 * i + 5] * sc); v.w = pk2(a[8 * i + 6] * sc, a[8 * i + 7] * sc); *(U4*)(p + 8 * i) = v; }
}

HDF void prep_body(bf16* QKV, int m, int slot, const LayerP& P, const F2* RT) {
    int s = slot, col0; const float* g; bool isq, rope;
    if (s < NAH) { col0 = C_AQ + 64 * s; g = P.aqn; isq = true; rope = false; }
    else if ((s -= NAH) < NAH) { col0 = C_AK + 64 * s; g = P.akn; isq = false; rope = false; }
    else if ((s -= NAH) < 2 * DFH) { col0 = C_BQ + 64 * s; g = P.bqn; isq = true; rope = true; }
    else if ((s -= 2 * DFH) < 2 * DFH) { col0 = C_BK + 64 * s; g = P.bkn; isq = false; rope = true; }
    else if ((s -= 2 * DFH) < SWH) { col0 = C_SQ + 64 * s; g = P.cqn; isq = true; rope = true; }
    else { s -= SWH; col0 = C_SK + 64 * s; g = P.ckn; isq = false; rope = true; }
    bool isctx; int b, t; row_decode(m, isctx, b, t);
    bf16* p = QKV + (size_t)m * NQKV + col0;
    float x[64]; load64(p, x);
    float ss = 0.f;
#pragma unroll
    for (int i = 0; i < 64; ++i) ss += x[i] * x[i];
    const float r = 1.0f / sqrtf(ss * (1.f / 64.f) + NORM_EPS);
#pragma unroll
    for (int i = 0; i < 64; ++i) x[i] = x[i] * r * g[i];
    if (rope && !isctx) {
#pragma unroll
        for (int pp = 0; pp < 2; ++pp) { const int pos = pp == 0 ? t / GW : t % GW;
#pragma unroll
            for (int f = 0; f < 16; ++f) { const F2 cs = RT[pos * 16 + f]; const float a = x[pp * 32 + f], b2 = x[pp * 32 + 16 + f];
                x[pp * 32 + f] = a * cs.x - b2 * cs.y; x[pp * 32 + 16 + f] = b2 * cs.x + a * cs.y; } }
    }
    store64(p, x, isq ? 0.125f : 1.0f);
}

HDF void pool_d_body(const bf16* QKV, bf16* DPOOL, int m, int c8) {
    bool isctx; int b, t; row_decode(m, isctx, b, t);
    const int T = isctx ? CL : S, ch = c8 * 8, g = ch / PGW, w = 2 << g;
    int lo = t - w / 2; if (lo < 0) lo = 0; int hi = t - w / 2 + w; if (hi > T) hi = T;
    const bf16* base = QKV + (size_t)(m - t) * NQKV + C_DU + ch;
    float sum[8];
#pragma unroll
    for (int i = 0; i < 8; ++i) sum[i] = 0.f;
    for (int j = lo; j < hi; ++j) { const U4 v = *(const U4*)(base + (size_t)j * NQKV);
        sum[0] += bflo(v.x); sum[1] += bfhi(v.x); sum[2] += bflo(v.y); sum[3] += bfhi(v.y); sum[4] += bflo(v.z); sum[5] += bfhi(v.z); sum[6] += bflo(v.w); sum[7] += bfhi(v.w); }
    const float inv = 1.0f / (float)(hi - lo);
    const U4 u = *(const U4*)(base + (size_t)t * NQKV);
    U4 o; o.x = pk2(sum[0] * inv - bflo(u.x), sum[1] * inv - bfhi(u.x)); o.y = pk2(sum[2] * inv - bflo(u.y), sum[3] * inv - bfhi(u.y));
    o.z = pk2(sum[4] * inv - bflo(u.z), sum[5] * inv - bfhi(u.z)); o.w = pk2(sum[6] * inv - bflo(u.w), sum[7] * inv - bfhi(u.w));
    *(U4*)(DPOOL + (size_t)m * MIXW + ch) = o;
}
HDF void pool_mm_body(const bf16* DPOOL, bf16* O, int m, int e, const LayerP& P) {
    const int g = e / PGW, eo = e - g * PGW; const bf16* dp = DPOOL + (size_t)m * MIXW + g * PGW; const float* w = P.dw + (size_t)g * PGW * PGW + eo;
    float acc = 0.f;
    for (int c = 0; c < PGW; ++c) acc += bf2f(dp[c]) * w[(size_t)c * PGW];
    O[(size_t)m * D + 3 * MIXW + e] = (bf16)f2bf(acc * P.dscale[e]);
}

HDF void na_body(const bf16* QKV, bf16* O, int m, int h, const LayerP& P) {
    bool isctx; int b, t; row_decode(m, isctx, b, t);
    float q[64], acc[64]; load64(QKV + (size_t)m * NQKV + C_AQ + 64 * h, q);
#pragma unroll
    for (int d = 0; d < 64; ++d) acc[d] = 0.f;
    float mx = -INFINITY, l = 0.f;
    if (!isctx) {
        const int r = t / GW, qc = t % GW;
        int rs = r - NAR / 2; if (rs < 0) rs = 0; if (rs > ROWS - NAR) rs = ROWS - NAR;
        int cs = qc - NAC / 2; if (cs < 0) cs = 0; if (cs > GW - NAC) cs = GW - NAC;
        for (int kk = 0; kk < NAR; ++kk) { const int krow = rs + kk, dr = krow - r + (NAR - 1);
            for (int kx = 0; kx < NAC; ++kx) { const int kc = cs + kx; const bf16* kp = QKV + (size_t)(b * S + krow * GW + kc) * NQKV;
                const float s = dot64(q, kp + C_AK + 64 * h) + P.rpb[(h * (2 * NAR - 1) + dr) * (2 * NAC - 1) + (kc - qc + NAC - 1)];
                osm_step(s, kp + C_AV + 64 * h, mx, l, acc); } }
    }
    for (int c = 0; c < CL; ++c) { const bf16* kp = QKV + (size_t)(M_LAT + b * CL + c) * NQKV;
        const float s = dot64(q, kp + C_AK + 64 * h); osm_step(s, kp + C_AV + 64 * h, mx, l, acc); }
    store64(O + (size_t)m * D + 64 * h, acc, 1.0f / l);
}
HDF void diff_body(const bf16* QKV, float* OB, int m, int h, int i, int vh) {
    bool isctx; int b, t; row_decode(m, isctx, b, t);
    float q[64], acc[64]; load64(QKV + (size_t)m * NQKV + C_BQ + 64 * (2 * h + i), q);
#pragma unroll
    for (int d = 0; d < 64; ++d) acc[d] = 0.f;
    float mx = -INFINITY, l = 0.f;
    const int ko = C_BK + 64 * (2 * h + i), vo = C_BV + 128 * h + 64 * vh;
    if (!isctx) for (int j = 0; j < S; ++j) { const bf16* kp = QKV + (size_t)(b * S + j) * NQKV; osm_step(dot64(q, kp + ko), kp + vo, mx, l, acc); }
    for (int c = 0; c < CL; ++c) { const bf16* kp = QKV + (size_t)(M_LAT + b * CL + c) * NQKV; osm_step(dot64(q, kp + ko), kp + vo, mx, l, acc); }
    float* o = OB + ((size_t)(m * DFH + h) * 2 + i) * 128 + vh * 64; const float il = 1.0f / l;
#pragma unroll
    for (int d = 0; d < 64; ++d) o[d] = acc[d] * il;
}
HDF void diff_fin_body(const float* OB, bf16* O, int m, int h, float lam, float lam_init, const LayerP& P) {
    const float* o0 = OB + (size_t)(m * DFH + h) * 256; const float* o1 = o0 + 128;
    float ss = 0.f;
    for (int e = 0; e < 128; ++e) { const float v = o0[e] - lam * o1[e]; ss += v * v; }
    const float r = (1.0f / sqrtf(ss * (1.f / 128.f) + NORM_EPS)) * (1.0f - lam_init);
    bf16* op = O + (size_t)m * D + MIXW + 128 * h;
    for (int e = 0; e < 128; ++e) { const float v = o0[e] - lam * o1[e]; op[e] = (bf16)f2bf(v * r * P.subln[e]); }
}
HDF void swa_body(const bf16* QKV, bf16* O, int m, int hq, const LayerP& P) {
    bool isctx; int b, t; row_decode(m, isctx, b, t);
    const int kv = hq / SG;
    float q[64], acc[64]; load64(QKV + (size_t)m * NQKV + C_SQ + 64 * hq, q);
#pragma unroll
    for (int d = 0; d < 64; ++d) acc[d] = 0.f;
    float mx = -INFINITY, l = 0.f;
    const int ko = C_SK + 64 * kv, vo = C_SV + 64 * kv;
    if (!isctx) { int j0 = t - SWW; if (j0 < 0) j0 = 0; int j1 = t + SWW; if (j1 > S - 1) j1 = S - 1;
        for (int j = j0; j <= j1; ++j) { const bf16* kp = QKV + (size_t)(b * S + j) * NQKV; osm_step(dot64(q, kp + ko), kp + vo, mx, l, acc); } }
    for (int c = 0; c < CL; ++c) { const bf16* kp = QKV + (size_t)(M_LAT + b * CL + c) * NQKV; osm_step(dot64(q, kp + ko), kp + vo, mx, l, acc); }
    { const float s = P.sink[hq];
        if (s > mx) { const float c = FEXP(mx - s); l *= c;
#pragma unroll
            for (int d = 0; d < 64; ++d) acc[d] *= c;
            mx = s; }
        l += FEXP(s - mx); }
    store64(O + (size_t)m * D + 2 * MIXW + 64 * hq, acc, 1.0f / l);
}

#ifndef HOST_EMU
#define GAS __attribute__((address_space(1)))
#define LAS __attribute__((address_space(3)))
typedef unsigned v4u __attribute__((ext_vector_type(4)));
typedef float f32x4 __attribute__((ext_vector_type(4)));
typedef short bf16x8 __attribute__((ext_vector_type(8)));
typedef unsigned u32x4 __attribute__((ext_vector_type(4)));

constexpr size_t MiB = 1u << 20;
constexpr size_t al(size_t x) { return (x + MiB - 1) / MiB * MiB; }
constexpr size_t WS_CTL = 0, CTL_ZERO_BYTES = 1 * MiB;
constexpr size_t WS_MISC = 1 * MiB;
constexpr size_t MISC_CACT = 0, MISC_RT = (size_t)(NB + 1) * D * 4, MISC_LAM = MISC_RT + 64 * 16 * 8;
constexpr size_t WS_MODV = 2 * MiB;
constexpr size_t WS_CTXR = WS_MODV + al((size_t)NL * (NB + 1) * 6 * D * 4);
constexpr size_t WS_WIN = WS_CTXR + al((size_t)M_CTX * D * 4);
constexpr size_t WS_WBR = WS_WIN + al((size_t)PROJW * D * 2);
constexpr size_t WS_WOUT = WS_WBR + al((size_t)4 * D * MIXW * 2);
constexpr size_t WS_WGU = WS_WOUT + al((size_t)D * D * 2);
constexpr size_t WS_WD = WS_WGU + al((size_t)2 * DFF * D * 2);
constexpr size_t WS_H = WS_WD + al((size_t)D * DFF * 2);
constexpr size_t WS_QKV = WS_H + al((size_t)MT * D * 2);
constexpr size_t WS_GATES = WS_QKV + al((size_t)MT * NQKV * 2);
constexpr size_t WS_DPOOL = WS_GATES + al((size_t)MT * NGATE * 2);
constexpr size_t WS_O = WS_DPOOL + al((size_t)MT * MIXW * 2);
constexpr size_t WS_TMP = WS_O + al((size_t)MT * D * 2);
constexpr size_t WS_END = WS_TMP + (size_t)256 * 256 * 256 * 4;
static_assert((size_t)MT * DFF * 2 <= (size_t)MT * NGATE * 2, "HID fits in GATES");
static_assert((size_t)MT * DFH * 2 * 128 * 4 <= al((size_t)MT * D * 2), "OB fits in H");
static_assert(MISC_LAM + 64 <= MiB, "misc");
constexpr int CW_BAR = 4096;

constexpr int RING_BYTES = 131072, LDSCTL_OFF = RING_BYTES, MISC_OFF = LDSCTL_OFF + 320, LDS_BYTES = 147456;
constexpr int NWAVES = 8, NTHR = 512;

#define LDS_WAIT() asm volatile("s_waitcnt lgkmcnt(0)" ::: "memory")
#define VM_WAIT() asm volatile("s_waitcnt vmcnt(0)" ::: "memory")

#define XB_TMO      128
#define XB_XCNT(j)  (256  + 64 * (j))
#define XB_XSUB(j)  (1280 + 64 * (j))
#define XB_XGEN(j)  (2304 + 64 * (j))
#define XB_TOP      3328
#define XB_TOPGEN   3392
#define XCD_BAR_WORDS 3456
#define XB_SPIN_CAP (1u << 21)
__device__ __forceinline__ unsigned xb_ld(unsigned* p)              { return __hip_atomic_load(p, __ATOMIC_RELAXED, __HIP_MEMORY_SCOPE_AGENT); }
__device__ __forceinline__ unsigned xb_add(unsigned* p, unsigned v) { return __hip_atomic_fetch_add(p, v, __ATOMIC_RELAXED, __HIP_MEMORY_SCOPE_AGENT); }
__device__ __forceinline__ unsigned xb_xcc_id() { return (unsigned)__builtin_amdgcn_s_getreg((3 << 11) | 20) & 0xFu; }
#define XB_SPIN(cond, bar) do { unsigned _sp = 0; while (cond) { __builtin_amdgcn_s_sleep(1); \
    if ((++_sp & 255u) == 0u) { if (xb_ld(&(bar)[XB_TMO])) break; if (_sp > XB_SPIN_CAP) { atomicAdd(&(bar)[XB_TMO], 1u); break; } } } } while (0)
struct XcdBarrier { unsigned* bar; unsigned x; volatile LAS unsigned* st; };
__device__ __forceinline__ XcdBarrier xcd_barrier_post(unsigned* bar, volatile LAS unsigned* st) {
    XcdBarrier b; b.bar = bar; b.x = xb_xcc_id(); b.st = st;
    if (threadIdx.x == 0) (void)xb_add(&bar[XB_XCNT(b.x)], 1u);
    return b;
}
__device__ __forceinline__ void xcd_barrier_complete(unsigned* bar, unsigned x, unsigned& nloc, unsigned& nx) {
    const unsigned G = gridDim.x * gridDim.y * gridDim.z;
    unsigned sum, cnt, mine, sp = 0u;
    for (;;) {
        sum = 0u; cnt = 0u; mine = 0u;
#pragma unroll
        for (unsigned j = 0; j < 16; ++j) { const unsigned c = xb_ld(&bar[XB_XCNT(j)]); sum += c; cnt += (c > 0u) ? 1u : 0u; mine = (j == x) ? c : mine; }
        if (sum == G) break;
        __builtin_amdgcn_s_sleep(1);
        if ((++sp & 255u) == 0u) { if (xb_ld(&bar[XB_TMO])) break; if (sp > XB_SPIN_CAP) { atomicAdd(&bar[XB_TMO], 1u); break; } }
    }
    nloc = mine > 0u ? mine : 1u; nx = cnt > 0u ? cnt : 1u;
}
__device__ __forceinline__ void xcd_barrier(const XcdBarrier& b) {
    asm volatile("s_waitcnt vmcnt(0)" ::: "memory");
    __syncthreads();
    if (threadIdx.x == 0) {
        unsigned* bar = b.bar;
        __builtin_amdgcn_s_waitcnt(0);
        unsigned nloc = b.st[0], nx = b.st[1];
        if (nloc == 0u) { xcd_barrier_complete(bar, b.x, nloc, nx); b.st[0] = nloc; b.st[1] = nx; }
        const unsigned old = xb_add(&bar[XB_XSUB(b.x)], 1u);
        const unsigned gen = old / nloc;
        if (old + 1u == (gen + 1u) * nloc) {
            __builtin_amdgcn_fence(__ATOMIC_RELEASE, "agent");
            asm volatile("s_waitcnt vmcnt(0)" ::: "memory");
            const unsigned og = xb_add(&bar[XB_TOP], 1u);
            const unsigned tg = og / nx;
            if (og + 1u == (tg + 1u) * nx) xb_add(&bar[XB_TOPGEN], 1u);
            else XB_SPIN(xb_ld(&bar[XB_TOPGEN]) == tg, bar);
            __builtin_amdgcn_fence(__ATOMIC_ACQUIRE, "agent");
            xb_add(&bar[XB_XGEN(b.x)], 1u);
            asm volatile("s_waitcnt vmcnt(0)" ::: "memory");
        } else {
            XB_SPIN(xb_ld(&bar[XB_XGEN(b.x)]) == gen, bar);
            __builtin_amdgcn_fence(__ATOMIC_ACQUIRE, "agent");
            asm volatile("s_waitcnt vmcnt(0)" ::: "memory");
        }
    }
    __syncthreads();
}

namespace pg8 {
constexpr int BM = 256, BK = 64, HALF = 128, HTB = HALF * BK * 2, NXCD = 8, WGM = 8;
__host__ __device__ __forceinline__ int lds_byte(int r, int c) { const int st = (r >> 4) * 2 + (c >> 5), rr = r & 15, cc = c & 31, ob = rr * 64 + cc * 2; return st * 1024 + (ob ^ (((ob >> 9) & 1) << 5)); }
__host__ __device__ __forceinline__ void stage_rc(int b, int& R, int& C) { const int st = b / 1024, sb = b % 1024, swz = sb ^ (((sb >> 9) & 1) << 5); R = (st >> 1) * 16 + swz / 64; C = (st & 1) * 32 + (swz % 64) / 2; }
__host__ __device__ __forceinline__ int perm32(int rho) { const int n = rho >> 4, i = rho & 15; return 8 * (i >> 2) + 4 * n + (i & 3); }

struct Unit { int pm, pn, tag; };
struct Gemm { const bf16* A; const bf16* Bt; int lda, ldb, K; };

__device__ __forceinline__ void rect_unit(int L, int nM, int nN, int& pm, int& pn) {
    const int nwg = nM * nN; int wgid = L;
    { const int q = nwg / NXCD, r = nwg % NXCD, xcd = wgid % NXCD, off = wgid / NXCD; wgid = (xcd < r ? xcd * (q + 1) : r * (q + 1) + (xcd - r) * q) + off; }
    const int nig = WGM * nN, gid = wgid / nig, fm = gid * WGM, gsz = (nM - fm) < WGM ? (nM - fm) : WGM;
    pm = fm + ((wgid % nig) % gsz); pn = (wgid % nig) / gsz;
}
struct Sched {
    int nM0, nN0, nM1, nN1, sub, G, c;
    size_t bsub;
    int asub;
    __device__ __forceinline__ bool next(int i, Unit& u) const {
        const int j = i / sub, tg = i - j * sub; const long L = (long)j * G + c; const int n0 = nM0 * nN0, n1 = nM1 * nN1;
        if (L >= n0 + n1) return false;
        if (L < n0) rect_unit((int)L, nM0, nN0, u.pm, u.pn); else { rect_unit((int)L - n0, nM1, nN1, u.pm, u.pn); u.pm += nM0; }
        u.tag = tg; return true;
    }
    __device__ __forceinline__ size_t aoff(const Unit& u, int lda) const { return (size_t)u.pm * 256 * lda + (size_t)u.tag * asub; }
    __device__ __forceinline__ size_t boff(const Unit& u, int ldb) const { return (size_t)u.pn * 256 * ldb + (size_t)u.tag * bsub; }
};

template <class Epi>
__device__ __forceinline__ void gemm_phase(LAS unsigned char* lds, const Gemm g, const Sched& S, const Epi& E) {
    int tid_ = threadIdx.x; asm volatile("" : "+v"(tid_));
    const int tid = tid_, wid = __builtin_amdgcn_readfirstlane(tid >> 6), lane = tid & 63, wr = wid >> 2, wc = wid & 3, fr = lane & 15, fq = lane >> 4;
    const int K = g.K, nt = K / BK;
    unsigned voffA[2], voffB[2];
#pragma unroll
    for (int i = 0; i < 2; ++i) { int R, C; stage_rc(tid * 16 + i * 8192, R, C); const int Rb = (R & ~31) + perm32(R & 31);
        voffA[i] = (unsigned)(R * g.lda + C) * 2u; voffB[i] = (unsigned)(Rb * g.ldb + C) * 2u; }
    const size_t kstep = (size_t)(BK * 2);
    const size_t hstepA = (size_t)HALF * g.lda * 2, hstepB = (size_t)HALF * g.ldb * 2;
    const unsigned ldsw = (unsigned)wid * 1024u;
    const int aoff = lds_byte(wr * 64 + fr, fq * 8), boff = lds_byte(wc * 32 + fr, fq * 8);
#define PG8_SA(b, h) (((b) * 2 + (h)) * HTB)
#define PG8_SB(b, h) ((4 + (b) * 2 + (h)) * HTB)
#define PG8_STAGE(bufoff, gbase, voff) do { _Pragma("unroll") for (int _i = 0; _i < 2; ++_i) \
        __builtin_amdgcn_global_load_lds((const unsigned*)((const char*)(gbase) + (voff)[_i]), (LAS unsigned*)(lds + (bufoff) + ldsw + _i * 8192), 16, 0, 0); } while (0)
#define PG8_LDA(dst, b, h) do { _Pragma("unroll") for (int m = 0; m < 4; ++m) _Pragma("unroll") for (int k = 0; k < 2; ++k) dst[m][k] = *(const LAS bf16x8*)(lds + PG8_SA(b, h) + aoff + m * 2048 + k * 1024); } while (0)
#define PG8_LDB(dst, b, h) do { _Pragma("unroll") for (int n = 0; n < 2; ++n) _Pragma("unroll") for (int k = 0; k < 2; ++k) dst[n][k] = *(const LAS bf16x8*)(lds + PG8_SB(b, h) + boff + n * 2048 + k * 1024); } while (0)
#define PG8_MMA(ai, bj, At, Bt) do { __builtin_amdgcn_s_setprio(1); _Pragma("unroll") for (int m = 0; m < 4; ++m) _Pragma("unroll") for (int n = 0; n < 2; ++n) _Pragma("unroll") for (int k = 0; k < 2; ++k) \
        acc[ai][bj][m][n] = __builtin_amdgcn_mfma_f32_16x16x32_bf16(Bt[n][k], At[m][k], acc[ai][bj][m][n], 0, 0, 0); __builtin_amdgcn_s_setprio(0); } while (0)
#define PG8_WAIT_V(n) asm volatile("s_waitcnt vmcnt(" #n ")" ::: "memory")
#define PG8_WAIT_L(n) asm volatile("s_waitcnt lgkmcnt(" #n ")" ::: "memory")
#define PG8_BAR __builtin_amdgcn_s_barrier()
#define PG8_SCHED __builtin_amdgcn_sched_barrier(0)
    Unit cur, nxt; int ui = 0;
    if (!S.next(0, cur)) return;
    f32x4 acc[2][2][4][2];
#pragma unroll
    for (int a = 0; a < 2; ++a)
#pragma unroll
        for (int b = 0; b < 2; ++b)
#pragma unroll
            for (int m = 0; m < 4; ++m)
#pragma unroll
                for (int n = 0; n < 2; ++n) acc[a][b][m][n] = (f32x4){0.f, 0.f, 0.f, 0.f};
    bf16x8 At[4][2], B0[2][2], B1[2][2];
    const char* cA = (const char*)(g.A + S.aoff(cur, g.lda)); const char* cB = (const char*)(g.Bt + S.boff(cur, g.ldb));
    PG8_STAGE(PG8_SB(0, 0), cB, voffB); PG8_STAGE(PG8_SB(0, 1), cB + hstepB, voffB); PG8_STAGE(PG8_SA(0, 0), cA, voffA); PG8_STAGE(PG8_SA(0, 1), cA + hstepA, voffA);
    if (wr == 1) PG8_BAR;
    PG8_WAIT_V(2); PG8_BAR;
    PG8_STAGE(PG8_SB(1, 0), cB + kstep, voffB); PG8_STAGE(PG8_SA(1, 0), cA + kstep, voffA); PG8_STAGE(PG8_SB(1, 1), cB + hstepB + kstep, voffB);
    PG8_WAIT_V(6); PG8_BAR;
    for (;;) {
        const bool has_next = S.next(ui + 1, nxt);
        const char* nA = has_next ? (const char*)(g.A + S.aoff(nxt, g.lda)) : cA; const char* nB = has_next ? (const char*)(g.Bt + S.boff(nxt, g.ldb)) : cB;
        for (int t = 0; t < nt; t += 2) {
            const bool last = (t == nt - 2);
            const char* a1 = cA + (size_t)(t + 1) * kstep;
            const char* a2 = last ? nA : cA + (size_t)(t + 2) * kstep; const char* b2 = last ? nB : cB + (size_t)(t + 2) * kstep;
            const char* a3 = a2 + kstep; const char* b3 = b2 + kstep;
            PG8_LDB(B0, 0, 0); PG8_LDB(B1, 0, 1); PG8_SCHED; PG8_LDA(At, 0, 0); PG8_STAGE(PG8_SA(1, 1), a1 + hstepA, voffA);
            PG8_WAIT_V(8); PG8_WAIT_L(0); PG8_BAR; PG8_MMA(0, 0, At, B0); PG8_MMA(0, 1, At, B1); PG8_BAR; PG8_SCHED;
            PG8_LDA(At, 0, 1); PG8_STAGE(PG8_SB(0, 0), b2, voffB); PG8_STAGE(PG8_SB(0, 1), b2 + hstepB, voffB); PG8_STAGE(PG8_SA(0, 0), a2, voffA);
            PG8_WAIT_V(8); PG8_WAIT_L(0); PG8_BAR; PG8_MMA(1, 0, At, B0); PG8_MMA(1, 1, At, B1); PG8_BAR; PG8_SCHED;
            PG8_LDB(B0, 1, 0); PG8_LDB(B1, 1, 1); PG8_SCHED; PG8_LDA(At, 1, 0); PG8_STAGE(PG8_SA(0, 1), a2 + hstepA, voffA);
            PG8_WAIT_V(8); PG8_WAIT_L(0); PG8_BAR; PG8_MMA(0, 0, At, B0); PG8_MMA(0, 1, At, B1); PG8_BAR; PG8_SCHED;
            PG8_LDA(At, 1, 1); PG8_STAGE(PG8_SB(1, 0), b3, voffB); PG8_STAGE(PG8_SB(1, 1), b3 + hstepB, voffB); PG8_STAGE(PG8_SA(1, 0), a3, voffA);
            PG8_WAIT_V(8); PG8_WAIT_L(0); PG8_BAR; PG8_MMA(1, 0, At, B0); PG8_MMA(1, 1, At, B1); PG8_BAR; PG8_SCHED;
        }
        if (wr == 0) PG8_BAR;
        E(acc, cur, wr, wc, fr, fq);
        if (!has_next) break;
#pragma unroll
        for (int a = 0; a < 2; ++a)
#pragma unroll
            for (int b = 0; b < 2; ++b)
#pragma unroll
                for (int m = 0; m < 4; ++m)
#pragma unroll
                    for (int n = 0; n < 2; ++n) acc[a][b][m][n] = (f32x4){0.f, 0.f, 0.f, 0.f};
        cur = nxt; cA = nA; cB = nB; ++ui;
        if (wr == 1) PG8_BAR;
    }
    PG8_WAIT_V(0);
    PG8_BAR;
#undef PG8_SA
#undef PG8_SB
#undef PG8_STAGE
#undef PG8_LDA
#undef PG8_LDB
#undef PG8_MMA
#undef PG8_WAIT_V
#undef PG8_WAIT_L
#undef PG8_BAR
#undef PG8_SCHED
}
}

__device__ __forceinline__ unsigned cvt_pk(float lo, float hi) { unsigned r; asm volatile("v_cvt_pk_bf16_f32 %0, %1, %2" : "=v"(r) : "v"(lo), "v"(hi)); return r; }
__device__ __forceinline__ float sigm(float x) { return __builtin_amdgcn_rcpf(1.0f + __expf(-x)); }

struct EpiWin {
    bf16* QKV; bf16* GATES;
    __device__ __forceinline__ void operator()(const f32x4 (&acc)[2][2][4][2], const pg8::Unit& u, int wr, int wc, int fr, int fq) const {
        const bool isg = u.pn >= NQKV / 256;
        bf16* base = isg ? GATES : QKV; const int ld = isg ? NGATE : NQKV; const int colt = (isg ? u.pn - NQKV / 256 : u.pn) * 256 + wc * 32 + 8 * fq;
        const int row0 = u.pm * 256 + wr * 64 + fr;
#pragma unroll
        for (int ai = 0; ai < 2; ++ai)
#pragma unroll
            for (int m = 0; m < 4; ++m) { bf16* rowp = base + (size_t)(row0 + ai * 128 + m * 16) * ld + colt;
#pragma unroll
                for (int bj = 0; bj < 2; ++bj) { f32x4 v0 = acc[ai][bj][m][0], v1 = acc[ai][bj][m][1];
                    if (isg) { v0 = (f32x4){sigm(v0[0]), sigm(v0[1]), sigm(v0[2]), sigm(v0[3])}; v1 = (f32x4){sigm(v1[0]), sigm(v1[1]), sigm(v1[2]), sigm(v1[3])}; }
                    u32x4 w; w.x = cvt_pk(v0[0], v0[1]); w.y = cvt_pk(v0[2], v0[3]); w.z = cvt_pk(v1[0], v1[1]); w.w = cvt_pk(v1[2], v1[3]);
                    *(u32x4*)(rowp + bj * 128) = w; } }
    }
};
struct EpiMerge {
    const bf16* GATES; bf16* ACC; f32x4* TMP;
    template <int MODE>
    __device__ __forceinline__ void run(const f32x4 (&acc)[2][2][4][2], const pg8::Unit& u, int wr, int wc, int fr, int fq) const {
        const int n = u.tag, row0 = u.pm * 256 + wr * 64 + fr, colt = u.pn * 256 + wc * 32 + 8 * fq; const int tid = threadIdx.x;
        const bf16* gp = GATES + (size_t)row0 * NGATE + (size_t)n * D + colt;
        bf16* ap = ACC + (size_t)row0 * D + colt;
        f32x4* tp = TMP + tid;
#pragma unroll
        for (int ai = 0; ai < 2; ++ai)
#pragma unroll
            for (int m = 0; m < 4; ++m) {
                asm volatile("" : "+v"(gp), "+v"(ap), "+v"(tp) :: "memory");
#pragma unroll
                for (int bj = 0; bj < 2; ++bj) {
                    const u32x4 gq = *(const u32x4*)(gp + bj * 128);
                    f32x4 v0 = acc[ai][bj][m][0] * (f32x4){bflo(gq.x), bfhi(gq.x), bflo(gq.y), bfhi(gq.y)}, v1 = acc[ai][bj][m][1] * (f32x4){bflo(gq.z), bfhi(gq.z), bflo(gq.w), bfhi(gq.w)};
                    if (MODE > 0) { v0 += tp[bj * 2 * NTHR]; v1 += tp[(bj * 2 + 1) * NTHR]; }
                    if (MODE < 2) { tp[bj * 2 * NTHR] = v0; tp[(bj * 2 + 1) * NTHR] = v1; }
                    else { u32x4 w; w.x = cvt_pk(v0[0], v0[1]); w.y = cvt_pk(v0[2], v0[3]); w.z = cvt_pk(v1[0], v1[1]); w.w = cvt_pk(v1[2], v1[3]);
                        *(u32x4*)(ap + bj * 128) = w; } }
                gp += (size_t)(m == 3 ? 128 - 48 : 16) * NGATE; ap += (size_t)(m == 3 ? 128 - 48 : 16) * D; tp += 4 * NTHR;
            }
    }
    __device__ __forceinline__ void operator()(const f32x4 (&acc)[2][2][4][2], const pg8::Unit& u, int wr, int wc, int fr, int fq) const {
        if (u.tag == 0) run<0>(acc, u, wr, wc, fr, fq); else if (u.tag == 3) run<2>(acc, u, wr, wc, fr, fq); else run<1>(acc, u, wr, wc, fr, fq);
    }
};
struct EpiResid {
    const float* src_lat; float* dst_lat; const float* src_ctx; float* dst_ctx; const float* modv; int chunk;
    __device__ __forceinline__ void operator()(const f32x4 (&acc)[2][2][4][2], const pg8::Unit& u, int wr, int wc, int fr, int fq) const {
        const int prow = u.pm * 256; const bool isctx = prow >= M_LAT;
        const int mrow = isctx ? NB : prow / S;
        const float* src = isctx ? src_ctx : src_lat; float* dst = isctx ? dst_ctx : dst_lat;
        const int row0 = (isctx ? prow - M_LAT : prow) + wr * 64 + fr, colt = u.pn * 256 + wc * 32 + 8 * fq;
        const float* gp = modv + (size_t)mrow * 6 * D + (size_t)chunk * D + colt;
        f32x4 gv[2][2];
#pragma unroll
        for (int bj = 0; bj < 2; ++bj)
#pragma unroll
            for (int n = 0; n < 2; ++n) gv[bj][n] = *(const f32x4*)(gp + bj * 128 + 4 * n);
        const float* sp = src + (size_t)row0 * D + colt; float* dp = dst + (size_t)row0 * D + colt;
#pragma unroll
        for (int ai = 0; ai < 2; ++ai)
#pragma unroll
            for (int m = 0; m < 4; ++m) {
                asm volatile("" : "+v"(sp), "+v"(dp) :: "memory");
#pragma unroll
                for (int bj = 0; bj < 2; ++bj)
#pragma unroll
                    for (int n = 0; n < 2; ++n) { const f32x4 s = *(const f32x4*)(sp + bj * 128 + 4 * n);
                        *(f32x4*)(dp + bj * 128 + 4 * n) = s + gv[bj][n] * acc[ai][bj][m][n]; }
                sp += (size_t)(m == 3 ? 128 - 48 : 16) * D; dp += (size_t)(m == 3 ? 128 - 48 : 16) * D;
            }
    }
};
struct EpiFfnUp {
    bf16* HID;
    __device__ __forceinline__ void operator()(const f32x4 (&acc)[2][2][4][2], const pg8::Unit& u, int wr, int wc, int fr, int fq) const {
        const int row0 = u.pm * 256 + wr * 64 + fr, col = u.pn * 128 + wc * 32 + 8 * fq;
#pragma unroll
        for (int ai = 0; ai < 2; ++ai)
#pragma unroll
            for (int m = 0; m < 4; ++m) { bf16* rowp = HID + (size_t)(row0 + ai * 128 + m * 16) * DFF + col;
                f32x4 h[2];
#pragma unroll
                for (int n = 0; n < 2; ++n) { const f32x4 g = acc[ai][0][m][n], up = acc[ai][1][m][n];
                    h[n] = (f32x4){g[0] * sigm(g[0]) * up[0], g[1] * sigm(g[1]) * up[1], g[2] * sigm(g[2]) * up[2], g[3] * sigm(g[3]) * up[3]}; }
                u32x4 w; w.x = cvt_pk(h[0][0], h[0][1]); w.y = cvt_pk(h[0][2], h[0][3]); w.z = cvt_pk(h[1][0], h[1][1]); w.w = cvt_pk(h[1][2], h[1][3]);
                *(u32x4*)rowp = w; }
    }
};

__device__ __forceinline__ float wave_sum(float v) {
#pragma unroll
    for (int o = 1; o < 64; o <<= 1) v += __shfl_xor(v, o);
    return v;
}
__device__ __forceinline__ void transpose_item(const float* W, int N, bf16* WT, int ldt, int k0, int n0, int drow0, LAS float* scr, int lane) {
#pragma unroll 8
    for (int i = 0; i < 32; ++i) { const int kk = 2 * i + (lane >> 5); scr[kk * 33 + (lane & 31)] = W[(size_t)(k0 + kk) * N + n0 + (lane & 31)]; }
    LDS_WAIT(); asm volatile("" ::: "memory");
    const int c = lane & 7;
#pragma unroll
    for (int j = 0; j < 4; ++j) { const int n = (lane >> 3) + 8 * j; const LAS float* s = scr + (8 * c) * 33 + n;
        v4u o; o.x = pk2(s[0 * 33], s[1 * 33]); o.y = pk2(s[2 * 33], s[3 * 33]); o.z = pk2(s[4 * 33], s[5 * 33]); o.w = pk2(s[6 * 33], s[7 * 33]);
        *(GAS v4u*)(WT + (size_t)(drow0 + n) * ldt + k0 + 8 * c) = o; }
    LDS_WAIT(); asm volatile("" ::: "memory");
}

__device__ __forceinline__ int launder_i(int i) { asm volatile("" : "+s"(i)); return i; }
struct Args { const float* in[29]; float* out; unsigned char* ws; int ph_lo, ph_hi; };
static_assert(sizeof(Args) == 29 * 8 + 8 + 8 + 8, "Args has no padding");

enum { I_X = 0, I_C, I_CTX, I_CCTX, I_WADA, I_BADA, I_NMIX, I_NFFN, I_WIN, I_AQN, I_AKN, I_RPB, I_BQN, I_BKN, I_LQ1, I_LK1, I_LQ2, I_LK2, I_SUBLN, I_CQN, I_CKN, I_SINK, I_DW, I_DSCALE, I_WBR, I_WOUT, I_WG, I_WU, I_WD };
constexpr int NPRO = 2, NPL = 10, NPHASE = NPRO + NL * NPL;

__global__ void __launch_bounds__(256) naive_k(Args args) {
    const int tid = threadIdx.x;
    const long gt = (long)blockIdx.x * 256 + tid, NGT = (long)gridDim.x * 256;
    unsigned char* ws = args.ws;
    unsigned* ctl = (unsigned*)(ws + WS_CTL);
    float* CACT = (float*)(ws + WS_MISC + MISC_CACT); F2* RT = (F2*)(ws + WS_MISC + MISC_RT); float* LAM = (float*)(ws + WS_MISC + MISC_LAM);
    float* MODV = (float*)(ws + WS_MODV); float* CTXR = (float*)(ws + WS_CTXR);
    bf16* WIN_T = (bf16*)(ws + WS_WIN); bf16* WBR_T = (bf16*)(ws + WS_WBR); bf16* WOUT_T = (bf16*)(ws + WS_WOUT); bf16* WGU_T = (bf16*)(ws + WS_WGU); bf16* WD_T = (bf16*)(ws + WS_WD);
    bf16* H = (bf16*)(ws + WS_H); float* OB = (float*)(ws + WS_H); bf16* QKV = (bf16*)(ws + WS_QKV); bf16* ACC = (bf16*)(ws + WS_QKV);
    bf16* GATES = (bf16*)(ws + WS_GATES); bf16* HID = (bf16*)(ws + WS_GATES); bf16* DPOOL = (bf16*)(ws + WS_DPOOL); bf16* O = (bf16*)(ws + WS_O);

    const int lo = args.ph_lo, hi = args.ph_hi;
#define IN(k) (lo <= (k) && (k) < hi)
#define AIN(i) (args.in[i])
    if (IN(0)) {
        for (long i = gt; i < (long)(NB + 1) * D; i += NGT) { const int r = (int)(i / D), k = (int)(i % D); const float v = r < NB ? AIN(I_C)[i] : AIN(I_CCTX)[k]; CACT[i] = v / (1.0f + expf(-v)); }
        for (long i = gt; i < 64 * 16; i += NGT) { const int pos = (int)(i / 16), f = (int)(i % 16); const float inv = powf(10000.0f, -(float)f / 16.0f); const float a = (float)pos * inv; F2 cs; cs.x = cosf(a); cs.y = sinf(a); RT[i] = cs; }
        if (gt < NL) { const int l = (int)gt; float s1 = 0.f, s2 = 0.f;
            for (int i = 0; i < HDIM; ++i) { s1 += AIN(I_LQ1)[l * HDIM + i] * AIN(I_LK1)[l * HDIM + i]; s2 += AIN(I_LQ2)[l * HDIM + i] * AIN(I_LK2)[l * HDIM + i]; }
            const float li = 0.8f - 0.6f * expf(-0.3f * (float)l); LAM[2 * l] = expf(s1) - expf(s2) + li; LAM[2 * l + 1] = li; }
    }
    if (IN(1)) {
        for (long i = gt; i < (long)NL * 6 * D; i += NGT) { const int l = (int)(i / (6 * D)), j = (int)(i % (6 * D));
            const float* w = AIN(I_WADA) + (size_t)l * D * 6 * D + j;
            float a[NB + 1];
#pragma unroll
            for (int r = 0; r <= NB; ++r) a[r] = 0.f;
#pragma unroll 4
            for (int k = 0; k < D; ++k) { const float wv = w[(size_t)k * 6 * D];
#pragma unroll
                for (int r = 0; r <= NB; ++r) a[r] += CACT[r * D + k] * wv; }
            const float bb = AIN(I_BADA)[(size_t)l * 6 * D + j];
#pragma unroll
            for (int r = 0; r <= NB; ++r) MODV[((size_t)l * (NB + 1) + r) * 6 * D + j] = a[r] + bb; }
    }

    for (int l = 0; l < NL; ++l) {
        const int pb = NPRO + l * NPL; const bool lastl = (l == NL - 1);
#define MAKE_P() LayerP P; P.aqn = AIN(I_AQN) + l * HDIM; P.akn = AIN(I_AKN) + l * HDIM; P.rpb = AIN(I_RPB) + (size_t)l * NAH * (2 * NAR - 1) * (2 * NAC - 1); \
        P.bqn = AIN(I_BQN) + l * HDIM; P.bkn = AIN(I_BKN) + l * HDIM; P.subln = AIN(I_SUBLN) + l * 128; P.cqn = AIN(I_CQN) + l * HDIM; P.ckn = AIN(I_CKN) + l * HDIM; \
        P.sink = AIN(I_SINK) + l * SWH; P.dw = AIN(I_DW) + (size_t)l * 4 * PGW * PGW; P.dscale = AIN(I_DSCALE) + l * MIXW
        if (IN(pb + 2)) {
            MAKE_P();
            for (long i = gt; i < (long)MT * NSLOT; i += NGT) { const int slot = (int)(i / MT), m = (int)(i % MT); prep_body(QKV, m, slot, P, RT); }
            const int pm_rows = lastl ? M_LAT : MT;
            for (long i = gt; i < (long)pm_rows * (MIXW / 8); i += NGT) { const int m = (int)(i / (MIXW / 8)), c8 = (int)(i % (MIXW / 8)); pool_d_body(QKV, DPOOL, m, c8); }
        }

        if (IN(pb + 3)) {
            MAKE_P();
            const int nr = lastl ? M_LAT : MT;
            for (long i = gt; i < (long)nr * NAH; i += NGT) { const int h = (int)(i / nr), m = (int)(i % nr); na_body(QKV, O, m, h, P); }
            for (long i = gt; i < (long)nr * SWH; i += NGT) { const int h = (int)(i / nr), m = (int)(i % nr); swa_body(QKV, O, m, h, P); }
            for (long i = gt; i < (long)nr * DFH * 4; i += NGT) { const int hh = (int)(i / nr), m = (int)(i % nr); diff_body(QKV, OB, m, hh >> 2, (hh >> 1) & 1, hh & 1); }
            for (long i = gt; i < (long)nr * MIXW; i += NGT) { const int m = (int)(i / MIXW), e = (int)(i % MIXW); pool_mm_body(DPOOL, O, m, e, P); }
        }
        if (IN(pb + 4)) {
            MAKE_P();
            const int nr = lastl ? M_LAT : MT; const float lam = LAM[2 * l], lami = LAM[2 * l + 1];
            for (long i = gt; i < (long)nr * DFH; i += NGT) { const int h = (int)(i / nr), m = (int)(i % nr); diff_fin_body(OB, O, m, h, lam, lami, P); }
        }

    }
#undef IN
#undef AIN
#undef MAKE_P
}

__global__ void __launch_bounds__(NTHR, 2) mega(Args args) {
    extern __shared__ __attribute__((aligned(16))) unsigned char lds_raw[];
    LAS unsigned char* lds = (LAS unsigned char*)lds_raw;
    const int tid = threadIdx.x, lane0 = tid & 63, wave = __builtin_amdgcn_readfirstlane(tid >> 6);
    const int G = gridDim.x, bx = blockIdx.x;
    const int gw = bx * NWAVES + wave, NGW = G * NWAVES;
    const long gt = (long)bx * NTHR + tid, NGT = (long)G * NTHR;
    unsigned char* ws = args.ws;
    unsigned* ctl = (unsigned*)(ws + WS_CTL);
    float* CACT = (float*)(ws + WS_MISC + MISC_CACT); F2* RT = (F2*)(ws + WS_MISC + MISC_RT); float* LAM = (float*)(ws + WS_MISC + MISC_LAM);
    float* MODV = (float*)(ws + WS_MODV); float* CTXR = (float*)(ws + WS_CTXR);
    bf16* WIN_T = (bf16*)(ws + WS_WIN); bf16* WBR_T = (bf16*)(ws + WS_WBR); bf16* WOUT_T = (bf16*)(ws + WS_WOUT); bf16* WGU_T = (bf16*)(ws + WS_WGU); bf16* WD_T = (bf16*)(ws + WS_WD);
    bf16* H = (bf16*)(ws + WS_H); float* OB = (float*)(ws + WS_H); bf16* QKV = (bf16*)(ws + WS_QKV); bf16* ACC = (bf16*)(ws + WS_QKV);
    bf16* GATES = (bf16*)(ws + WS_GATES); bf16* HID = (bf16*)(ws + WS_GATES); bf16* DPOOL = (bf16*)(ws + WS_DPOOL); bf16* O = (bf16*)(ws + WS_O);
    f32x4* TMP = (f32x4*)(ws + WS_TMP) + (size_t)bx * (256 * 256 / 4);

    for (int u = tid; u < (LDS_BYTES - LDSCTL_OFF) / 4; u += NTHR) ((LAS unsigned*)(lds + LDSCTL_OFF))[u] = 0u;
    __syncthreads();
    const int lo = args.ph_lo, hi = args.ph_hi;
    XcdBarrier bar; bar.bar = ctl + CW_BAR; bar.x = 0; bar.st = nullptr;
    if (hi - lo > 1) bar = xcd_barrier_post(ctl + CW_BAR, (volatile LAS unsigned*)(lds + MISC_OFF) + 8);
#define IN(k) (lo <= (k) && (k) < hi)
#define AIN(i) (args.in[launder_i(i)])
#define SEAM(k) do { if (IN(k) && IN((k) + 1)) xcd_barrier(bar); } while (0)

    SEAM(0); SEAM(1);
    for (int l = 0; l < NL; ++l) {
        const int pb = NPRO + l * NPL; const bool lastl = (l == NL - 1);
        const float* modl = MODV + (size_t)l * (NB + 1) * 6 * D;
#define XSRC() (l == 0 ? AIN(I_X) : (const float*)args.out)
#define CSRC() (l == 0 ? AIN(I_CTX) : (const float*)CTXR)

        if (IN(pb + 0)) {
            int lane = lane0; asm volatile("" : "+v"(lane));
            LAS float* scr = (LAS float*)(lds + wave * 16384);
            constexpr int I_IN = (D / 64) * (PROJW / 32), I_BR = (MIXW / 64) * (D / 32), I_OUT = (D / 64) * (D / 32), I_GU = (D / 64) * (DFF / 32), I_DN = (DFF / 64) * (D / 32);
            constexpr int NIT = I_IN + 4 * I_BR + I_OUT + 2 * I_GU + I_DN;
            for (int it = gw; it < NIT; it += NGW) {
                int r = it;
                if (r < I_IN) { const int nb = PROJW / 32, kb = r / nb, n0 = (r % nb) * 32; transpose_item(AIN(I_WIN) + (size_t)l * D * PROJW, PROJW, WIN_T, D, kb * 64, n0, n0, scr, lane); continue; } r -= I_IN;
                if (r < 4 * I_BR) { const int n = r / I_BR, rr = r % I_BR, nb = D / 32, kb = rr / nb, n0 = (rr % nb) * 32;
                    transpose_item(AIN(I_WBR) + ((size_t)l * 4 + n) * MIXW * D, D, WBR_T + (size_t)n * D * MIXW, MIXW, kb * 64, n0, n0, scr, lane); continue; } r -= 4 * I_BR;
                if (r < I_OUT) { const int nb = D / 32, kb = r / nb, n0 = (r % nb) * 32; transpose_item(AIN(I_WOUT) + (size_t)l * D * D, D, WOUT_T, D, kb * 64, n0, n0, scr, lane); continue; } r -= I_OUT;
                if (r < 2 * I_GU) { const int up = r / I_GU, rr = r % I_GU, nb = DFF / 32, kb = rr / nb, n0 = (rr % nb) * 32;
                    transpose_item(AIN(up ? I_WU : I_WG) + (size_t)l * D * DFF, DFF, WGU_T, D, kb * 64, n0, (n0 / 128) * 256 + (n0 % 128) + up * 128, scr, lane); continue; } r -= 2 * I_GU;
                { const int nb = D / 32, kb = r / nb, n0 = (r % nb) * 32; transpose_item(AIN(I_WD) + (size_t)l * DFF * D, D, WD_T, DFF, kb * 64, n0, n0, scr, lane); }
            }
        }
#define NORM_PHASE(nrows, gainp, CH_SH, CH_SC, srcl, srcc) do { int lane = lane0; asm volatile("" : "+v"(lane)); \
            for (int m = gw; m < (nrows); m += NGW) { const bool isc = m >= M_LAT; \
                const float* xr = isc ? (srcc) + (size_t)(m - M_LAT) * D : (srcl) + (size_t)m * D; \
                const float* mr = modl + (size_t)(isc ? NB : m / S) * 6 * D; \
                f32x4 v[D / 256]; float ss = 0.f; \
                _Pragma("unroll") for (int j = 0; j < D / 256; ++j) { v[j] = *(const f32x4*)(xr + 4 * lane + 256 * j); ss += (v[j].x * v[j].x + v[j].y * v[j].y) + (v[j].z * v[j].z + v[j].w * v[j].w); } \
                const float rs = 1.0f / sqrtf(wave_sum(ss) * (1.0f / D) + NORM_EPS); \
                _Pragma("unroll") for (int j = 0; j < D / 256; ++j) { const int c = 4 * lane + 256 * j; \
                    const f32x4 gn = *(const f32x4*)((gainp) + c), sh = *(const f32x4*)(mr + (CH_SH) * D + c), sc = *(const f32x4*)(mr + (CH_SC) * D + c); \
                    const f32x4 y = (v[j] * rs * gn) * (sc + 1.0f) + sh; \
                    unsigned long long o = (unsigned long long)pk2(y.x, y.y) | ((unsigned long long)pk2(y.z, y.w) << 32); \
                    *(unsigned long long*)(H + (size_t)m * D + c) = o; } } } while (0)
        if (IN(pb + 0)) { const float* xs_ = XSRC(); const float* cs_ = CSRC(); NORM_PHASE(MT, AIN(I_NMIX) + (size_t)l * D, 0, 1, xs_, cs_); }
        SEAM(pb + 0);

        if (IN(pb + 1)) {
            pg8::Gemm g{H, WIN_T, D, D, D};
            pg8::Sched Sd{M_LAT / 256, PROJW / 256, M_CTX / 256, lastl ? NQKV / 256 : PROJW / 256, 1, G, bx, 0, 0};
            EpiWin E{QKV, GATES};
            pg8::gemm_phase<EpiWin>(lds, g, Sd, E);
        }
        SEAM(pb + 1);

        SEAM(pb + 2); SEAM(pb + 3); SEAM(pb + 4);

        if (IN(pb + 5)) {
            pg8::Gemm g{O, WBR_T, D, MIXW, MIXW};
            pg8::Sched Sd{M_LAT / 256, D / 256, lastl ? 0 : M_CTX / 256, D / 256, 4, G, bx, (size_t)D * MIXW, MIXW};
            EpiMerge E{GATES, ACC, TMP};
            pg8::gemm_phase<EpiMerge>(lds, g, Sd, E);
        }
        SEAM(pb + 5);

        if (IN(pb + 6)) {
            pg8::Gemm g{ACC, WOUT_T, D, D, D};
            pg8::Sched Sd{M_LAT / 256, D / 256, lastl ? 0 : M_CTX / 256, D / 256, 1, G, bx, 0, 0};
            EpiResid E{XSRC(), args.out, CSRC(), CTXR, modl, 2};
            pg8::gemm_phase<EpiResid>(lds, g, Sd, E);
        }
        SEAM(pb + 6);

        if (IN(pb + 7)) { const int nr = lastl ? M_LAT : MT; NORM_PHASE(nr, AIN(I_NFFN) + (size_t)l * D, 3, 4, args.out, CTXR); }
        SEAM(pb + 7);

        if (IN(pb + 8)) {
            pg8::Gemm g{H, WGU_T, D, D, D};
            pg8::Sched Sd{M_LAT / 256, 2 * DFF / 256, lastl ? 0 : M_CTX / 256, 2 * DFF / 256, 1, G, bx, 0, 0};
            EpiFfnUp E{HID};
            pg8::gemm_phase<EpiFfnUp>(lds, g, Sd, E);
        }
        SEAM(pb + 8);

        if (IN(pb + 9)) {
            pg8::Gemm g{HID, WD_T, DFF, DFF, DFF};
            pg8::Sched Sd{M_LAT / 256, D / 256, lastl ? 0 : M_CTX / 256, D / 256, 1, G, bx, 0, 0};
            EpiResid E{args.out, args.out, CTXR, CTXR, modl, 5};
            pg8::gemm_phase<EpiResid>(lds, g, Sd, E);
        }
        SEAM(pb + 9);
    }
#undef IN
#undef SEAM
#undef AIN
#undef XSRC
#undef CSRC
#undef NORM_PHASE
}

#ifndef MK_PER_PHASE
#define MK_PER_PHASE 1
#endif
extern "C" void kernel_launch(void* const* d_in, const int* in_sizes, int n_in, void* d_out, int out_size, void* d_ws, size_t ws_size, hipStream_t stream) {
    static int grid = 0;
    if (grid == 0) {
        if (n_in != 29 || out_size != M_LAT * D || ws_size < WS_END) { fprintf(stderr, "kernel_launch: unexpected shapes (n_in %d out %d ws %zu need %zu)\n", n_in, out_size, ws_size, (size_t)WS_END); grid = -1; return; }
        int dev = 0, cus = 0, per_cu = 0;
        if (hipGetDevice(&dev) != hipSuccess || hipDeviceGetAttribute(&cus, hipDeviceAttributeMultiprocessorCount, dev) != hipSuccess) { grid = -1; return; }
        if (hipFuncSetAttribute((const void*)mega, hipFuncAttributeMaxDynamicSharedMemorySize, LDS_BYTES) != hipSuccess) { fprintf(stderr, "kernel_launch: hipFuncSetAttribute failed\n"); grid = -1; return; }
        if (hipOccupancyMaxActiveBlocksPerMultiprocessor(&per_cu, (const void*)mega, NTHR, LDS_BYTES) != hipSuccess || per_cu < 1) fprintf(stderr, "kernel_launch: occupancy query reports %d\n", per_cu);
        (void)hipGetLastError();
        grid = cus > 256 ? 256 : cus;
    }
    if (grid < 0) return;
    if (hipMemsetAsync((char*)d_ws + WS_CTL, 0, CTL_ZERO_BYTES, stream) != hipSuccess) return;
    Args a{};
    for (int i = 0; i < 29; ++i) a.in[i] = (const float*)d_in[i];
    a.out = (float*)d_out; a.ws = (unsigned char*)d_ws;
#if MK_PER_PHASE
    for (int p = 0; p < NPHASE; ++p) { a.ph_lo = p; a.ph_hi = p + 1;
        const int sub = p < NPRO ? -1 : (p - NPRO) % NPL;
        if (p < NPRO || sub == 2 || sub == 3 || sub == 4) hipLaunchKernelGGL(naive_k, dim3(2048), dim3(256), 0, stream, a);
        else hipLaunchKernelGGL(mega, dim3(grid), dim3(NTHR), LDS_BYTES, stream, a); }
#else
    a.ph_lo = 0; a.ph_hi = NPHASE; hipLaunchKernelGGL(mega, dim3(grid), dim3(NTHR), LDS_BYTES, stream, a);
#endif
}
#endif
```

```cpp
#ifndef HOST_EMU
#include <hip/hip_runtime.h>
#endif
#include <cstdio>
#include <cstdint>
#include <cmath>
#include <cstring>

#ifndef CFG_D
#define CFG_D 2048
#endif
#ifndef CFG_B
#define CFG_B 16
#endif
#ifndef CFG_S
#define CFG_S 2048
#endif
#ifndef CFG_L
#define CFG_L 4
#endif
#ifndef CFG_CL
#define CFG_CL 256
#endif
constexpr int D = CFG_D, NB = CFG_B, S = CFG_S, NL = CFG_L, CL = CFG_CL;
constexpr int GW = 64, HDIM = 64, MIXW = D / 4, NAH = MIXW / 64, DFH = MIXW / 128, SWH = MIXW / 64, SKV = 2, SG = SWH / SKV;
constexpr int PGW = MIXW / 4, DFF = ((8 * D + 767) / 768) * 256, ROWS = S / GW, NAR = 8, NAC = 16, SWW = 128;
constexpr int C_AQ = 0, C_AK = MIXW, C_AV = 2 * MIXW, C_BQ = 3 * MIXW, C_BK = 4 * MIXW, C_BV = 5 * MIXW, C_SQ = 6 * MIXW, C_SK = 7 * MIXW, C_SV = 7 * MIXW + SKV * HDIM, C_DU = 7 * MIXW + 2 * SKV * HDIM;
constexpr int NQKV = C_DU + MIXW, NGATE = 4 * D, PROJW = NQKV + NGATE;
constexpr int M_LAT = NB * S, M_CTX = NB * CL, MT = M_LAT + M_CTX;
constexpr int NSLOT = 2 * NAH + 4 * DFH + SWH + SKV;
constexpr float NORM_EPS = 1e-6f;
static_assert(ROWS >= NAR && ROWS <= 64, "grid rows");

#ifdef HOST_EMU
#define HDF inline
#define FEXP(x) expf(x)
#else
#define HDF __device__ __forceinline__
#define FEXP(x) __expf(x)
#endif

typedef unsigned short bf16;
struct alignas(16) U4 { unsigned x, y, z, w; };
struct alignas(8) F2 { float x, y; };

HDF float bf2f(bf16 h) { unsigned u = (unsigned)h << 16; float f; memcpy(&f, &u, 4); return f; }
HDF float bflo(unsigned u) { unsigned v = u << 16; float f; memcpy(&f, &v, 4); return f; }
HDF float bfhi(unsigned u) { unsigned v = u & 0xffff0000u; float f; memcpy(&f, &v, 4); return f; }
HDF unsigned f2bf(float f) { unsigned u; memcpy(&u, &f, 4); return (u + 0x7fffu + ((u >> 16) & 1u)) >> 16; }
HDF unsigned pk2(float lo, float hi) { return f2bf(lo) | (f2bf(hi) << 16); }

struct LayerP { const float *aqn, *akn, *rpb, *bqn, *bkn, *subln, *cqn, *ckn, *sink, *dw, *dscale; };

HDF void row_decode(int m, bool& isctx, int& b, int& t) {
    isctx = m >= M_LAT;
    if (!isctx) { b = m / S; t = m - b * S; } else { const int r = m - M_LAT; b = r / CL; t = r - b * CL; }
}

HDF void load64(const bf16* p, float (&x)[64]) {
#pragma unroll
    for (int i = 0; i < 8; ++i) { const U4 v = *(const U4*)(p + 8 * i);
        x[8 * i + 0] = bflo(v.x); x[8 * i + 1] = bfhi(v.x); x[8 * i + 2] = bflo(v.y); x[8 * i + 3] = bfhi(v.y);
        x[8 * i + 4] = bflo(v.z); x[8 * i + 5] = bfhi(v.z); x[8 * i + 6] = bflo(v.w); x[8 * i + 7] = bfhi(v.w); }
}
HDF float dot64(const float (&q)[64], const bf16* p) {
    float s0 = 0.f, s1 = 0.f;
#pragma unroll
    for (int i = 0; i < 8; ++i) { const U4 v = *(const U4*)(p + 8 * i);
        s0 += q[8 * i + 0] * bflo(v.x); s1 += q[8 * i + 1] * bfhi(v.x); s0 += q[8 * i + 2] * bflo(v.y); s1 += q[8 * i + 3] * bfhi(v.y);
        s0 += q[8 * i + 4] * bflo(v.z); s1 += q[8 * i + 5] * bfhi(v.z); s0 += q[8 * i + 6] * bflo(v.w); s1 += q[8 * i + 7] * bfhi(v.w); }
    return s0 + s1;
}
HDF void osm_step(float s, const bf16* vrow, float& mx, float& l, float (&acc)[64]) {
    if (s > mx) { const float c = FEXP(mx - s); l *= c;
#pragma unroll
        for (int d = 0; d < 64; ++d) acc[d] *= c;
        mx = s; }
    const float p = FEXP(s - mx); l += p;
#pragma unroll
    for (int i = 0; i < 8; ++i) { const U4 v = *(const U4*)(vrow + 8 * i);
        acc[8 * i + 0] += p * bflo(v.x); acc[8 * i + 1] += p * bfhi(v.x); acc[8 * i + 2] += p * bflo(v.y); acc[8 * i + 3] += p * bfhi(v.y);
        acc[8 * i + 4] += p * bflo(v.z); acc[8 * i + 5] += p * bfhi(v.z); acc[8 * i + 6] += p * bflo(v.w); acc[8 * i + 7] += p * bfhi(v.w); }
}
HDF void store64(bf16* p, const float (&a)[64], float sc) {
#pragma unroll
    for (int i = 0; i < 8; ++i) { U4 v; v.x = pk2(a[8 * i] * sc, a[8 * i + 1] * sc); v.y = pk2(a[8 * i + 2] * sc, a[8 * i + 3] * sc);
        v.z = pk2(a[8 * i + 4] * sc, a[8 * i + 5] * sc); v.w = pk2(a[8 * i + 6] * sc, a[8 * i + 7] * sc); *(U4*)(p + 8 * i) = v; }
}

HDF void prep_body(bf16* QKV, int m, int slot, const LayerP& P, const F2* RT) {
    int s = slot, col0; const float* g; bool isq, rope;
    if (s < NAH) { col0 = C_AQ + 64 * s; g = P.aqn; isq = true; rope = false; }
    else if ((s -= NAH) < NAH) { col0 = C_AK + 64 * s; g = P.akn; isq = false; rope = false; }
    else if ((s -= NAH) < 2 * DFH) { col0 = C_BQ + 64 * s; g = P.bqn; isq = true; rope = true; }
    else if ((s -= 2 * DFH) < 2 * DFH) { col0 = C_BK + 64 * s; g = P.bkn; isq = false; rope = true; }
    else if ((s -= 2 * DFH) < SWH) { col0 = C_SQ + 64 * s; g = P.cqn; isq = true; rope = true; }
    else { s -= SWH; col0 = C_SK + 64 * s; g = P.ckn; isq = false; rope = true; }
    bool isctx; int b, t; row_decode(m, isctx, b, t);
    bf16* p = QKV + (size_t)m * NQKV + col0;
    float x[64]; load64(p, x);
    float ss = 0.f;
#pragma unroll
    for (int i = 0; i < 64; ++i) ss += x[i] * x[i];
    const float r = 1.0f / sqrtf(ss * (1.f / 64.f) + NORM_EPS);
#pragma unroll
    for (int i = 0; i < 64; ++i) x[i] = x[i] * r * g[i];
    if (rope && !isctx) {
#pragma unroll
        for (int pp = 0; pp < 2; ++pp) { const int pos = pp == 0 ? t / GW : t % GW;
#pragma unroll
            for (int f = 0; f < 16; ++f) { const F2 cs = RT[pos * 16 + f]; const float a = x[pp * 32 + f], b2 = x[pp * 32 + 16 + f];
                x[pp * 32 + f] = a * cs.x - b2 * cs.y; x[pp * 32 + 16 + f] = b2 * cs.x + a * cs.y; } }
    }
    store64(p, x, isq ? 0.125f : 1.0f);
}

HDF void pool_d_body(const bf16* QKV, bf16* OUT, int ldo, int m, int c8) {
    bool isctx; int b, t; row_decode(m, isctx, b, t);
    const int T = isctx ? CL : S, ch = c8 * 8, g = ch / PGW, w = 2 << g;
    int lo = t - w / 2; if (lo < 0) lo = 0; int hi = t - w / 2 + w; if (hi > T) hi = T;
    const bf16* base = QKV + (size_t)(m - t) * NQKV + C_DU + ch;
    float sum[8];
#pragma unroll
    for (int i = 0; i < 8; ++i) sum[i] = 0.f;
    for (int j = lo; j < hi; ++j) { const U4 v = *(const U4*)(base + (size_t)j * NQKV);
        sum[0] += bflo(v.x); sum[1] += bfhi(v.x); sum[2] += bflo(v.y); sum[3] += bfhi(v.y); sum[4] += bflo(v.z); sum[5] += bfhi(v.z); sum[6] += bflo(v.w); sum[7] += bfhi(v.w); }
    const float inv = 1.0f / (float)(hi - lo);
    const U4 u = *(const U4*)(base + (size_t)t * NQKV);
    U4 o; o.x = pk2(sum[0] * inv - bflo(u.x), sum[1] * inv - bfhi(u.x)); o.y = pk2(sum[2] * inv - bflo(u.y), sum[3] * inv - bfhi(u.y));
    o.z = pk2(sum[4] * inv - bflo(u.z), sum[5] * inv - bfhi(u.z)); o.w = pk2(sum[6] * inv - bflo(u.w), sum[7] * inv - bfhi(u.w));
    *(U4*)(OUT + (size_t)m * ldo + ch) = o;
}
HDF void pool_mm_body(const bf16* DPOOL, bf16* O, int m, int e, const LayerP& P) {
    const int g = e / PGW, eo = e - g * PGW; const bf16* dp = DPOOL + (size_t)m * MIXW + g * PGW; const float* w = P.dw + (size_t)g * PGW * PGW + eo;
    float acc = 0.f;
    for (int c = 0; c < PGW; ++c) acc += bf2f(dp[c]) * w[(size_t)c * PGW];
    O[(size_t)m * D + 3 * MIXW + e] = (bf16)f2bf(acc * P.dscale[e]);
}

HDF void na_body(const bf16* QKV, bf16* O, int m, int h, const LayerP& P) {
    bool isctx; int b, t; row_decode(m, isctx, b, t);
    float q[64], acc[64]; load64(QKV + (size_t)m * NQKV + C_AQ + 64 * h, q);
#pragma unroll
    for (int d = 0; d < 64; ++d) acc[d] = 0.f;
    float mx = -INFINITY, l = 0.f;
    if (!isctx) {
        const int r = t / GW, qc = t % GW;
        int rs = r - NAR / 2; if (rs < 0) rs = 0; if (rs > ROWS - NAR) rs = ROWS - NAR;
        int cs = qc - NAC / 2; if (cs < 0) cs = 0; if (cs > GW - NAC) cs = GW - NAC;
        for (int kk = 0; kk < NAR; ++kk) { const int krow = rs + kk, dr = krow - r + (NAR - 1);
            for (int kx = 0; kx < NAC; ++kx) { const int kc = cs + kx; const bf16* kp = QKV + (size_t)(b * S + krow * GW + kc) * NQKV;
                const float s = dot64(q, kp + C_AK + 64 * h) + P.rpb[(h * (2 * NAR - 1) + dr) * (2 * NAC - 1) + (kc - qc + NAC - 1)];
                osm_step(s, kp + C_AV + 64 * h, mx, l, acc); } }
    }
    for (int c = 0; c < CL; ++c) { const bf16* kp = QKV + (size_t)(M_LAT + b * CL + c) * NQKV;
        const float s = dot64(q, kp + C_AK + 64 * h); osm_step(s, kp + C_AV + 64 * h, mx, l, acc); }
    store64(O + (size_t)m * D + 64 * h, acc, 1.0f / l);
}
HDF void diff_body(const bf16* QKV, float* OB, int m, int h, int i, int vh) {
    bool isctx; int b, t; row_decode(m, isctx, b, t);
    float q[64], acc[64]; load64(QKV + (size_t)m * NQKV + C_BQ + 64 * (2 * h + i), q);
#pragma unroll
    for (int d = 0; d < 64; ++d) acc[d] = 0.f;
    float mx = -INFINITY, l = 0.f;
    const int ko = C_BK + 64 * (2 * h + i), vo = C_BV + 128 * h + 64 * vh;
    if (!isctx) for (int j = 0; j < S; ++j) { const bf16* kp = QKV + (size_t)(b * S + j) * NQKV; osm_step(dot64(q, kp + ko), kp + vo, mx, l, acc); }
    for (int c = 0; c < CL; ++c) { const bf16* kp = QKV + (size_t)(M_LAT + b * CL + c) * NQKV; osm_step(dot64(q, kp + ko), kp + vo, mx, l, acc); }
    float* o = OB + ((size_t)(m * DFH + h) * 2 + i) * 128 + vh * 64; const float il = 1.0f / l;
#pragma unroll
    for (int d = 0; d < 64; ++d) o[d] = acc[d] * il;
}
HDF void diff_fin_body(const float* OB, bf16* O, int m, int h, float lam, float lam_init, const LayerP& P) {
    const float* o0 = OB + (size_t)(m * DFH + h) * 256; const float* o1 = o0 + 128;
    float ss = 0.f;
    for (int e = 0; e < 128; ++e) { const float v = o0[e] - lam * o1[e]; ss += v * v; }
    const float r = (1.0f / sqrtf(ss * (1.f / 128.f) + NORM_EPS)) * (1.0f - lam_init);
    bf16* op = O + (size_t)m * D + MIXW + 128 * h;
    for (int e = 0; e < 128; ++e) { const float v = o0[e] - lam * o1[e]; op[e] = (bf16)f2bf(v * r * P.subln[e]); }
}
HDF void swa_body(const bf16* QKV, bf16* O, int m, int hq, const LayerP& P) {
    bool isctx; int b, t; row_decode(m, isctx, b, t);
    const int kv = hq / SG;
    float q[64], acc[64]; load64(QKV + (size_t)m * NQKV + C_SQ + 64 * hq, q);
#pragma unroll
    for (int d = 0; d < 64; ++d) acc[d] = 0.f;
    float mx = -INFINITY, l = 0.f;
    const int ko = C_SK + 64 * kv, vo = C_SV + 64 * kv;
    if (!isctx) { int j0 = t - SWW; if (j0 < 0) j0 = 0; int j1 = t + SWW; if (j1 > S - 1) j1 = S - 1;
        for (int j = j0; j <= j1; ++j) { const bf16* kp = QKV + (size_t)(b * S + j) * NQKV; osm_step(dot64(q, kp + ko), kp + vo, mx, l, acc); } }
    for (int c = 0; c < CL; ++c) { const bf16* kp = QKV + (size_t)(M_LAT + b * CL + c) * NQKV; osm_step(dot64(q, kp + ko), kp + vo, mx, l, acc); }
    { const float s = P.sink[hq];
        if (s > mx) { const float c = FEXP(mx - s); l *= c;
#pragma unroll
            for (int d = 0; d < 64; ++d) acc[d] *= c;
            mx = s; }
        l += FEXP(s - mx); }
    store64(O + (size_t)m * D + 2 * MIXW + 64 * hq, acc, 1.0f / l);
}

#ifndef HOST_EMU
#define GAS __attribute__((address_space(1)))
#define LAS __attribute__((address_space(3)))
typedef unsigned v4u __attribute__((ext_vector_type(4)));
typedef float f32x4 __attribute__((ext_vector_type(4)));
typedef short bf16x8 __attribute__((ext_vector_type(8)));
typedef unsigned u32x4 __attribute__((ext_vector_type(4)));

constexpr size_t MiB = 1u << 20;
constexpr size_t al(size_t x) { return (x + MiB - 1) / MiB * MiB; }
constexpr size_t WS_CTL = 0, CTL_ZERO_BYTES = 1 * MiB;
constexpr size_t WS_MISC = 1 * MiB;
constexpr size_t MISC_CACT = 0, MISC_RT = (size_t)(NB + 1) * D * 4, MISC_LAM = MISC_RT + 64 * 16 * 8;
constexpr size_t WS_MODV = 2 * MiB;
constexpr size_t WS_CTXR = WS_MODV + al((size_t)NL * (NB + 1) * 6 * D * 4);
constexpr size_t WS_WIN = WS_CTXR + al((size_t)M_CTX * D * 4);
constexpr size_t WS_WBR = WS_WIN + al((size_t)PROJW * D * 2);
constexpr size_t WS_WOUT = WS_WBR + al((size_t)4 * D * MIXW * 2);
constexpr size_t WS_WGU = WS_WOUT + al((size_t)D * D * 2);
constexpr size_t WS_WD = WS_WGU + al((size_t)2 * DFF * D * 2);
constexpr size_t WS_H = WS_WD + al((size_t)D * DFF * 2);
constexpr size_t WS_QKV = WS_H + al((size_t)MT * D * 2);
constexpr size_t WS_GATES = WS_QKV + al((size_t)MT * NQKV * 2);
constexpr size_t WS_DPOOL = WS_GATES + al((size_t)MT * NGATE * 2);
constexpr size_t WS_O = WS_DPOOL + al((size_t)MT * MIXW * 2);
constexpr size_t WS_TMP = WS_O + al((size_t)MT * D * 2);
constexpr size_t WS_VT = WS_TMP + (size_t)256 * 256 * 256 * 4;
constexpr size_t WS_XB = WS_TMP;
constexpr size_t WS_END0 = WS_VT + al((size_t)(2 * MIXW + SKV * HDIM) * MT * 2);
constexpr size_t WS_END1 = (WS_XB + al((size_t)MT * D * 2)) > WS_END0 ? (WS_XB + al((size_t)MT * D * 2)) : WS_END0;
constexpr size_t WS_W2 = WS_END1;
constexpr size_t WS_WSET = WS_H - WS_WBR;
constexpr size_t WS_END = WS_W2 + WS_WSET;
static_assert((size_t)MT * DFF * 2 <= (size_t)MT * NGATE * 2, "HID fits in GATES");
static_assert((size_t)MT * DFH * 2 * 128 * 4 <= al((size_t)MT * D * 2), "OB fits in H");
static_assert(MISC_LAM + 64 + NL * 192 * 4 <= MiB, "misc");
constexpr int CW_BAR = 4096;

constexpr int RING_BYTES = 131072, LDSCTL_OFF = RING_BYTES, MISC_OFF = LDSCTL_OFF + 320, LDS_BYTES = 147456;
constexpr int NWAVES = 8, NTHR = 512;

#define LDS_WAIT() asm volatile("s_waitcnt lgkmcnt(0)" ::: "memory")
#define VM_WAIT() asm volatile("s_waitcnt vmcnt(0)" ::: "memory")

#define XB_TMO      128
#define XB_XCNT(j)  (256  + 64 * (j))
#define XB_XSUB(j)  (1280 + 64 * (j))
#define XB_XGEN(j)  (2304 + 64 * (j))
#define XB_TOP      3328
#define XB_TOPGEN   3392
#define XCD_BAR_WORDS 3456
#define XB_SPIN_CAP (1u << 21)
__device__ __forceinline__ unsigned xb_ld(unsigned* p)              { return __hip_atomic_load(p, __ATOMIC_RELAXED, __HIP_MEMORY_SCOPE_AGENT); }
__device__ __forceinline__ unsigned xb_add(unsigned* p, unsigned v) { return __hip_atomic_fetch_add(p, v, __ATOMIC_RELAXED, __HIP_MEMORY_SCOPE_AGENT); }
__device__ __forceinline__ unsigned xb_xcc_id() { return (unsigned)__builtin_amdgcn_s_getreg((3 << 11) | 20) & 0xFu; }
#define XB_SPIN(cond, bar) do { unsigned _sp = 0; while (cond) { __builtin_amdgcn_s_sleep(1); \
    if ((++_sp & 255u) == 0u) { if (xb_ld(&(bar)[XB_TMO])) break; if (_sp > XB_SPIN_CAP) { atomicAdd(&(bar)[XB_TMO], 1u); break; } } } } while (0)
struct XcdBarrier { unsigned* bar; unsigned x; volatile LAS unsigned* st; };
__device__ __forceinline__ XcdBarrier xcd_barrier_post(unsigned* bar, volatile LAS unsigned* st) {
    XcdBarrier b; b.bar = bar; b.x = xb_xcc_id(); b.st = st;
    if (threadIdx.x == 0) (void)xb_add(&bar[XB_XCNT(b.x)], 1u);
    return b;
}
__device__ __forceinline__ void xcd_barrier_complete(unsigned* bar, unsigned x, unsigned& nloc, unsigned& nx) {
    const unsigned G = gridDim.x * gridDim.y * gridDim.z;
    unsigned sum, cnt, mine, sp = 0u;
    for (;;) {
        sum = 0u; cnt = 0u; mine = 0u;
#pragma unroll
        for (unsigned j = 0; j < 16; ++j) { const unsigned c = xb_ld(&bar[XB_XCNT(j)]); sum += c; cnt += (c > 0u) ? 1u : 0u; mine = (j == x) ? c : mine; }
        if (sum == G) break;
        __builtin_amdgcn_s_sleep(1);
        if ((++sp & 255u) == 0u) { if (xb_ld(&bar[XB_TMO])) break; if (sp > XB_SPIN_CAP) { atomicAdd(&bar[XB_TMO], 1u); break; } }
    }
    nloc = mine > 0u ? mine : 1u; nx = cnt > 0u ? cnt : 1u;
}
__device__ __forceinline__ void xcd_barrier(const XcdBarrier& b) {
    asm volatile("s_waitcnt vmcnt(0)" ::: "memory");
    __syncthreads();
    if (threadIdx.x == 0) {
        unsigned* bar = b.bar;
        __builtin_amdgcn_s_waitcnt(0);
        unsigned nloc = b.st[0], nx = b.st[1];
        if (nloc == 0u) { xcd_barrier_complete(bar, b.x, nloc, nx); b.st[0] = nloc; b.st[1] = nx; }
        const unsigned old = xb_add(&bar[XB_XSUB(b.x)], 1u);
        const unsigned gen = old / nloc;
        if (old + 1u == (gen + 1u) * nloc) {
            __builtin_amdgcn_fence(__ATOMIC_RELEASE, "agent");
            asm volatile("s_waitcnt vmcnt(0)" ::: "memory");
            const unsigned og = xb_add(&bar[XB_TOP], 1u);
            const unsigned tg = og / nx;
            if (og + 1u == (tg + 1u) * nx) xb_add(&bar[XB_TOPGEN], 1u);
            else XB_SPIN(xb_ld(&bar[XB_TOPGEN]) == tg, bar);
            __builtin_amdgcn_fence(__ATOMIC_ACQUIRE, "agent");
            xb_add(&bar[XB_XGEN(b.x)], 1u);
            asm volatile("s_waitcnt vmcnt(0)" ::: "memory");
        } else {
            XB_SPIN(xb_ld(&bar[XB_XGEN(b.x)]) == gen, bar);
            __builtin_amdgcn_fence(__ATOMIC_ACQUIRE, "agent");
            asm volatile("s_waitcnt vmcnt(0)" ::: "memory");
        }
    }
    __syncthreads();
}

namespace pg8 {
constexpr int BM = 256, BK = 64, HALF = 128, HTB = HALF * BK * 2, NXCD = 8, WGM = 4;
__host__ __device__ __forceinline__ int lds_byte(int r, int c) { const int st = (r >> 4) * 2 + (c >> 5), rr = r & 15, cc = c & 31, ob = rr * 64 + cc * 2; return st * 1024 + (ob ^ (((ob >> 9) & 1) << 5)); }
__host__ __device__ __forceinline__ void stage_rc(int b, int& R, int& C) { const int st = b / 1024, sb = b % 1024, swz = sb ^ (((sb >> 9) & 1) << 5); R = (st >> 1) * 16 + swz / 64; C = (st & 1) * 32 + (swz % 64) / 2; }
__host__ __device__ __forceinline__ int perm32(int rho) { const int n = rho >> 4, i = rho & 15; return 8 * (i >> 2) + 4 * n + (i & 3); }

struct Unit { int pm, pn, tag, half; };
struct Gemm { const bf16* A; const bf16* Bt; int lda, ldb, K; };

__device__ __forceinline__ void rect_unit(int L, int nM, int nN, int& pm, int& pn) {
    const int nwg = nM * nN; int wgid = L;
    { const int q = nwg / NXCD, r = nwg % NXCD, xcd = wgid % NXCD, off = wgid / NXCD; wgid = (xcd < r ? xcd * (q + 1) : r * (q + 1) + (xcd - r) * q) + off; }
    const int nig = WGM * nN, gid = wgid / nig, fm = gid * WGM, gsz = (nM - fm) < WGM ? (nM - fm) : WGM;
    pm = fm + ((wgid % nig) % gsz); pn = (wgid % nig) / gsz;
}
struct Sched {
    int nM0, nN0, nM1, nN1, sub, G, c;
    size_t bsub;
    int asub;
    int rev;
    int ksplit;
    __device__ __forceinline__ bool next(int i, Unit& u) const {
        const int j = i / sub, tg = i - j * sub; long L = (long)j * G + c; const int n0 = nM0 * nN0, n1 = nM1 * nN1 * (ksplit ? 2 : 1);
        if (L >= n0 + n1) return false;
        if (rev) L = (long)(n0 + n1 - 1) - L;
        u.tag = tg; u.half = 0;
        if (L < n0) rect_unit((int)L, nM0, nN0, u.pm, u.pn);
        else if (!ksplit) { rect_unit((int)L - n0, nM1, nN1, u.pm, u.pn); u.pm += nM0; }
        else { rect_unit((int)L - n0, nM1, 2 * nN1, u.pm, u.pn); u.pm += nM0; u.half = 1; u.tag = u.pn >= nN1 ? 1 : 0; u.pn -= u.tag * nN1; }
        return true;
    }
    __device__ __forceinline__ size_t aoff(const Unit& u, int lda) const { return (size_t)u.pm * 256 * lda + (size_t)u.tag * asub; }
    __device__ __forceinline__ size_t boff(const Unit& u, int ldb) const { return (size_t)u.pn * 256 * ldb + (size_t)u.tag * bsub; }
};

template <class Epi>
__device__ __forceinline__ void gemm_phase(LAS unsigned char* lds, const Gemm g, const Sched& S, const Epi& E) {
    int tid_ = threadIdx.x; asm volatile("" : "+v"(tid_));
    const int tid = tid_, wid = __builtin_amdgcn_readfirstlane(tid >> 6), lane = tid & 63, wr = wid >> 2, wc = wid & 3, fr = lane & 15, fq = lane >> 4;
    const int K = g.K, nt = K / BK;
    unsigned voffA[2], voffB[2];
#pragma unroll
    for (int i = 0; i < 2; ++i) { int R, C; stage_rc(tid * 16 + i * 8192, R, C); const int Rb = (R & ~31) + perm32(R & 31);
        voffA[i] = (unsigned)(R * g.lda + C) * 2u; voffB[i] = (unsigned)(Rb * g.ldb + C) * 2u; }
    const size_t kstep = (size_t)(BK * 2);
    const size_t hstepA = (size_t)HALF * g.lda * 2, hstepB = (size_t)HALF * g.ldb * 2;
    const unsigned ldsw = (unsigned)wid * 1024u;
    const int aoff = lds_byte(wr * 64 + fr, fq * 8), boff = lds_byte(wc * 32 + fr, fq * 8);
#define PG8_SA(b, h) (((b) * 2 + (h)) * HTB)
#define PG8_SB(b, h) ((4 + (b) * 2 + (h)) * HTB)
#define PG8_STAGE(bufoff, gbase, voff) do { _Pragma("unroll") for (int _i = 0; _i < 2; ++_i) \
        __builtin_amdgcn_global_load_lds((const unsigned*)((const char*)(gbase) + (voff)[_i]), (LAS unsigned*)(lds + (bufoff) + ldsw + _i * 8192), 16, 0, 0); } while (0)
#define PG8_LDA(dst, b, h) do { _Pragma("unroll") for (int m = 0; m < 4; ++m) _Pragma("unroll") for (int k = 0; k < 2; ++k) dst[m][k] = *(const LAS bf16x8*)(lds + PG8_SA(b, h) + aoff + m * 2048 + k * 1024); } while (0)
#define PG8_LDB(dst, b, h) do { _Pragma("unroll") for (int n = 0; n < 2; ++n) _Pragma("unroll") for (int k = 0; k < 2; ++k) dst[n][k] = *(const LAS bf16x8*)(lds + PG8_SB(b, h) + boff + n * 2048 + k * 1024); } while (0)
#define PG8_MMA(ai, bj, At, Bt) do { __builtin_amdgcn_s_setprio(1); _Pragma("unroll") for (int m = 0; m < 4; ++m) _Pragma("unroll") for (int n = 0; n < 2; ++n) _Pragma("unroll") for (int k = 0; k < 2; ++k) \
        acc[ai][bj][m][n] = __builtin_amdgcn_mfma_f32_16x16x32_bf16(Bt[n][k], At[m][k], acc[ai][bj][m][n], 0, 0, 0); __builtin_amdgcn_s_setprio(0); } while (0)
#define PG8_WAIT_V(n) asm volatile("s_waitcnt vmcnt(" #n ")" ::: "memory")
#define PG8_WAIT_L(n) asm volatile("s_waitcnt lgkmcnt(" #n ")" ::: "memory")
#define PG8_BAR __builtin_amdgcn_s_barrier()
#define PG8_SCHED __builtin_amdgcn_sched_barrier(0)
    Unit cur, nxt; int ui = 0;
    if (!S.next(0, cur)) return;
    f32x4 acc[2][2][4][2];
#pragma unroll
    for (int a = 0; a < 2; ++a)
#pragma unroll
        for (int b = 0; b < 2; ++b)
#pragma unroll
            for (int m = 0; m < 4; ++m)
#pragma unroll
                for (int n = 0; n < 2; ++n) acc[a][b][m][n] = (f32x4){0.f, 0.f, 0.f, 0.f};
    bf16x8 At[4][2], B0[2][2], B1[2][2];
    const char* cA = (const char*)(g.A + S.aoff(cur, g.lda)); const char* cB = (const char*)(g.Bt + S.boff(cur, g.ldb));
    PG8_STAGE(PG8_SB(0, 0), cB, voffB); PG8_STAGE(PG8_SB(0, 1), cB + hstepB, voffB); PG8_STAGE(PG8_SA(0, 0), cA, voffA); PG8_STAGE(PG8_SA(0, 1), cA + hstepA, voffA);
    if (wr == 1) PG8_BAR;
    PG8_WAIT_V(2); PG8_BAR;
    PG8_STAGE(PG8_SB(1, 0), cB + kstep, voffB); PG8_STAGE(PG8_SA(1, 0), cA + kstep, voffA); PG8_STAGE(PG8_SB(1, 1), cB + hstepB + kstep, voffB);
    PG8_WAIT_V(6); PG8_BAR;
    for (;;) {
        const bool has_next = S.next(ui + 1, nxt);
        const char* nA = has_next ? (const char*)(g.A + S.aoff(nxt, g.lda)) : cA; const char* nB = has_next ? (const char*)(g.Bt + S.boff(nxt, g.ldb)) : cB;
        const int ntu = cur.half ? nt >> 1 : nt;
        for (int t = 0; t < ntu; t += 2) {
            const bool last = (t == ntu - 2);
            const char* a1 = cA + (size_t)(t + 1) * kstep;
            const char* a2 = last ? nA : cA + (size_t)(t + 2) * kstep; const char* b2 = last ? nB : cB + (size_t)(t + 2) * kstep;
            const char* a3 = a2 + kstep; const char* b3 = b2 + kstep;
            PG8_LDB(B0, 0, 0); PG8_LDB(B1, 0, 1); PG8_SCHED; PG8_LDA(At, 0, 0); PG8_STAGE(PG8_SA(1, 1), a1 + hstepA, voffA);
            PG8_WAIT_V(8); PG8_WAIT_L(0); PG8_BAR; PG8_MMA(0, 0, At, B0); PG8_MMA(0, 1, At, B1); PG8_BAR; PG8_SCHED;
            PG8_LDA(At, 0, 1); PG8_STAGE(PG8_SB(0, 0), b2, voffB); PG8_STAGE(PG8_SB(0, 1), b2 + hstepB, voffB); PG8_STAGE(PG8_SA(0, 0), a2, voffA);
            PG8_WAIT_V(8); PG8_WAIT_L(0); PG8_BAR; PG8_MMA(1, 0, At, B0); PG8_MMA(1, 1, At, B1); PG8_BAR; PG8_SCHED;
            PG8_LDB(B0, 1, 0); PG8_LDB(B1, 1, 1); PG8_SCHED; PG8_LDA(At, 1, 0); PG8_STAGE(PG8_SA(0, 1), a2 + hstepA, voffA);
            PG8_WAIT_V(8); PG8_WAIT_L(0); PG8_BAR; PG8_MMA(0, 0, At, B0); PG8_MMA(0, 1, At, B1); PG8_BAR; PG8_SCHED;
            PG8_LDA(At, 1, 1); PG8_STAGE(PG8_SB(1, 0), b3, voffB); PG8_STAGE(PG8_SB(1, 1), b3 + hstepB, voffB); PG8_STAGE(PG8_SA(1, 0), a3, voffA);
            PG8_WAIT_V(8); PG8_WAIT_L(0); PG8_BAR; PG8_MMA(1, 0, At, B0); PG8_MMA(1, 1, At, B1); PG8_BAR; PG8_SCHED;
        }
        if (wr == 0) PG8_BAR;
        E(acc, cur, wr, wc, fr, fq);
        if (!has_next) break;
#pragma unroll
        for (int a = 0; a < 2; ++a)
#pragma unroll
            for (int b = 0; b < 2; ++b)
#pragma unroll
                for (int m = 0; m < 4; ++m)
#pragma unroll
                    for (int n = 0; n < 2; ++n) acc[a][b][m][n] = (f32x4){0.f, 0.f, 0.f, 0.f};
        cur = nxt; cA = nA; cB = nB; ++ui;
        if (wr == 1) PG8_BAR;
    }
    PG8_WAIT_V(0);
    PG8_BAR;
#undef PG8_SA
#undef PG8_SB
#undef PG8_STAGE
#undef PG8_LDA
#undef PG8_LDB
#undef PG8_MMA
#undef PG8_WAIT_V
#undef PG8_WAIT_L
#undef PG8_BAR
#undef PG8_SCHED
}
}

__device__ __forceinline__ unsigned cvt_pk(float lo, float hi) { unsigned r; asm volatile("v_cvt_pk_bf16_f32 %0, %1, %2" : "=v"(r) : "v"(lo), "v"(hi)); return r; }
__device__ __forceinline__ float sigm(float x) { return __builtin_amdgcn_rcpf(1.0f + __expf(-x)); }

__host__ __device__ constexpr bool is_ktile(int pn) { return pn == C_AK / 256 || pn == C_AK / 256 + 1 || pn == C_BK / 256 || pn == C_BK / 256 + 1 || pn == C_SK / 256; }
__host__ __device__ constexpr int kperm_row(int n0) { return is_ktile(n0 / 256) ? (n0 & ~255) + (((n0 & 63) >> 5) * 128) + (((n0 & 255) >> 6) * 32) + (n0 & 31) : n0; }
static_assert(C_AK % 256 == 0 && C_BK % 256 == 0 && C_SK % 256 == 0 && MIXW == 512 && SKV * HDIM == 128, "k tile geometry");
using u32x2 = __attribute__((ext_vector_type(2))) unsigned;
__device__ __forceinline__ unsigned pk4u8(float a, float b, float c, float d) {
    const unsigned ua = __builtin_bit_cast(unsigned, fmaf(a, 255.f, 8388608.f)), ub = __builtin_bit_cast(unsigned, fmaf(b, 255.f, 8388608.f));
    const unsigned uc = __builtin_bit_cast(unsigned, fmaf(c, 255.f, 8388608.f)), ud = __builtin_bit_cast(unsigned, fmaf(d, 255.f, 8388608.f));
    const unsigned lo = __builtin_amdgcn_perm(ub, ua, 0x0c0c0400u), hi = __builtin_amdgcn_perm(ud, uc, 0x0c0c0400u);
    return __builtin_amdgcn_perm(hi, lo, 0x05040100u);
}
__device__ __forceinline__ f32x4 u8x4f(unsigned u) { return (f32x4){(float)(u & 0xffu), (float)((u >> 8) & 0xffu), (float)((u >> 16) & 0xffu), (float)(u >> 24)}; }
struct EpiWin {
    bf16* QKV; unsigned char* GATES; const float* kg; const F2* RT;
    __device__ __forceinline__ void operator()(const f32x4 (&acc)[2][2][4][2], const pg8::Unit& u, int wr, int wc, int fr, int fq) const {
        const bool isg = u.pn >= NQKV / 256;
        const int row0 = u.pm * 256 + wr * 64 + fr;
        if (!isg && is_ktile(u.pn)) {
            const bool sk = u.pn == C_SK / 256; const bool norm = !sk || wc < 2;
            const bool rope = u.pn != C_AK / 256 && u.pn != C_AK / 256 + 1 && norm && u.pm * 256 < M_LAT;
            const float* g = kg + ((u.pn == C_AK / 256 || u.pn == C_AK / 256 + 1) ? 0 : (sk ? 128 : 64));
            f32x4 gv[2][2];
#pragma unroll
            for (int bj = 0; bj < 2; ++bj)
#pragma unroll
                for (int n = 0; n < 2; ++n) gv[bj][n] = *(const f32x4*)(g + 32 * bj + 8 * fq + 4 * n);
            const int colk = u.pn * 256 + 64 * wc + 8 * fq;
#pragma unroll
            for (int ai = 0; ai < 2; ++ai)
#pragma unroll
                for (int m = 0; m < 4; ++m) { const int row = row0 + ai * 128 + m * 16;
                    f32x4 x[2][2]; float ss = 0.f;
#pragma unroll
                    for (int bj = 0; bj < 2; ++bj)
#pragma unroll
                        for (int n = 0; n < 2; ++n) { x[bj][n] = acc[ai][bj][m][n]; ss += (x[bj][n].x * x[bj][n].x + x[bj][n].y * x[bj][n].y) + (x[bj][n].z * x[bj][n].z + x[bj][n].w * x[bj][n].w); }
                    ss += __shfl_xor(ss, 16); ss += __shfl_xor(ss, 32);
                    const float rs = norm ? 1.0f / sqrtf(ss * (1.f / 64.f) + NORM_EPS) : 1.0f;
#pragma unroll
                    for (int bj = 0; bj < 2; ++bj)
#pragma unroll
                        for (int n = 0; n < 2; ++n) { if (norm) x[bj][n] = x[bj][n] * rs * gv[bj][n]; }
                    if (rope) { const int t = row % S; const bool hi = fq >= 2;
#pragma unroll
                        for (int bj = 0; bj < 2; ++bj) { const int pos = bj == 0 ? t / GW : t % GW;
#pragma unroll
                            for (int n = 0; n < 2; ++n)
#pragma unroll
                                for (int j = 0; j < 4; ++j) { const float own = x[bj][n][j], o = __shfl_xor(own, 32); const F2 cs = RT[pos * 16 + 8 * (fq & 1) + 4 * n + j];
                                    x[bj][n][j] = hi ? own * cs.x + o * cs.y : own * cs.x - o * cs.y; } } }
                    bf16* rowp = QKV + (size_t)row * NQKV + colk;
#pragma unroll
                    for (int bj = 0; bj < 2; ++bj) { u32x4 w; w.x = cvt_pk(x[bj][0][0], x[bj][0][1]); w.y = cvt_pk(x[bj][0][2], x[bj][0][3]); w.z = cvt_pk(x[bj][1][0], x[bj][1][1]); w.w = cvt_pk(x[bj][1][2], x[bj][1][3]);
                        *(u32x4*)(rowp + 32 * bj) = w; } }
            return;
        }
        if (isg) {
            const int colt = (u.pn - NQKV / 256) * 256 + wc * 32 + 8 * fq;
#pragma unroll
            for (int ai = 0; ai < 2; ++ai)
#pragma unroll
                for (int m = 0; m < 4; ++m) { unsigned char* rowp = GATES + (size_t)(row0 + ai * 128 + m * 16) * NGATE + colt;
#pragma unroll
                    for (int bj = 0; bj < 2; ++bj) { const f32x4 v0 = acc[ai][bj][m][0], v1 = acc[ai][bj][m][1];
                        u32x2 w; w.x = pk4u8(sigm(v0[0]), sigm(v0[1]), sigm(v0[2]), sigm(v0[3])); w.y = pk4u8(sigm(v1[0]), sigm(v1[1]), sigm(v1[2]), sigm(v1[3]));
                        *(u32x2*)(rowp + bj * 128) = w; } }
            return;
        }
        const int colt = u.pn * 256 + wc * 32 + 8 * fq;
#pragma unroll
        for (int ai = 0; ai < 2; ++ai)
#pragma unroll
            for (int m = 0; m < 4; ++m) { bf16* rowp = QKV + (size_t)(row0 + ai * 128 + m * 16) * NQKV + colt;
#pragma unroll
                for (int bj = 0; bj < 2; ++bj) { const f32x4 v0 = acc[ai][bj][m][0], v1 = acc[ai][bj][m][1];
                    u32x4 w; w.x = cvt_pk(v0[0], v0[1]); w.y = cvt_pk(v0[2], v0[3]); w.z = cvt_pk(v1[0], v1[1]); w.w = cvt_pk(v1[2], v1[3]);
                    *(u32x4*)(rowp + bj * 128) = w; } }
    }
};
struct EpiMerge {
    const bf16* GATES; bf16* ACC; u32x4* TMP;
    template <int MODE>
    __device__ __forceinline__ void run(const f32x4 (&acc)[2][2][4][2], const pg8::Unit& u, int wr, int wc, int fr, int fq) const {
        const int n = u.tag, row0 = u.pm * 256 + wr * 64 + fr, colt = u.pn * 256 + wc * 32 + 8 * fq; const int tid = threadIdx.x;
        const bf16* gp = GATES + (size_t)row0 * NGATE + (size_t)n * D + colt;
        bf16* ap = ACC + (size_t)row0 * D + colt;
        u32x4* tp = TMP + tid;
#pragma unroll
        for (int ai = 0; ai < 2; ++ai)
#pragma unroll
            for (int mp = 0; mp < 2; ++mp) {
                asm volatile("" : "+v"(gp), "+v"(ap), "+v"(tp) :: "memory");
                u32x4 gq[2][2], tv[2][2];
#pragma unroll
                for (int mm = 0; mm < 2; ++mm)
#pragma unroll
                    for (int bj = 0; bj < 2; ++bj) { gq[mm][bj] = *(const u32x4*)(gp + (size_t)mm * 16 * NGATE + bj * 128);
                        if (MODE > 0) tv[mm][bj] = tp[(mm * 2 + bj) * NTHR]; }
#pragma unroll
                for (int mm = 0; mm < 2; ++mm)
#pragma unroll
                    for (int bj = 0; bj < 2; ++bj) { const int m = mp * 2 + mm; const u32x4 g4 = gq[mm][bj];
                        f32x4 v0 = acc[ai][bj][m][0] * (f32x4){bflo(g4.x), bfhi(g4.x), bflo(g4.y), bfhi(g4.y)}, v1 = acc[ai][bj][m][1] * (f32x4){bflo(g4.z), bfhi(g4.z), bflo(g4.w), bfhi(g4.w)};
                        if (MODE > 0) { const u32x4 t4 = tv[mm][bj]; v0 += (f32x4){bflo(t4.x), bfhi(t4.x), bflo(t4.y), bfhi(t4.y)}; v1 += (f32x4){bflo(t4.z), bfhi(t4.z), bflo(t4.w), bfhi(t4.w)}; }
                        u32x4 w; w.x = cvt_pk(v0[0], v0[1]); w.y = cvt_pk(v0[2], v0[3]); w.z = cvt_pk(v1[0], v1[1]); w.w = cvt_pk(v1[2], v1[3]);
                        if (MODE < 2) tp[(mm * 2 + bj) * NTHR] = w;
                        else *(u32x4*)(ap + (size_t)mm * 16 * D + bj * 128) = w; }
                gp += (size_t)(mp == 1 ? 128 - 32 : 32) * NGATE; ap += (size_t)(mp == 1 ? 128 - 32 : 32) * D; tp += 4 * NTHR;
            }
    }
    __device__ __forceinline__ void operator()(const f32x4 (&acc)[2][2][4][2], const pg8::Unit& u, int wr, int wc, int fr, int fq) const {
        if (u.tag == 0) run<0>(acc, u, wr, wc, fr, fq); else if (u.tag == 3) run<2>(acc, u, wr, wc, fr, fq); else run<1>(acc, u, wr, wc, fr, fq);
    }
};
struct EpiResid {
    bf16* xb; float* outf; float* pb; const float* modv; int chunk;
    __device__ __forceinline__ void operator()(const f32x4 (&acc)[2][2][4][2], const pg8::Unit& u, int wr, int wc, int fr, int fq) const {
        const int prow = u.pm * 256; const bool isctx = prow >= M_LAT;
        const int mrow = isctx ? NB : prow / S;
        const int row0 = prow + wr * 64 + fr, colt = u.pn * 256 + wc * 32 + 8 * fq;
        const float* gp = modv + (size_t)mrow * 6 * D + (size_t)chunk * D + colt;
        f32x4 gv[2][2];
#pragma unroll
        for (int bj = 0; bj < 2; ++bj)
#pragma unroll
            for (int n = 0; n < 2; ++n) gv[bj][n] = *(const f32x4*)(gp + bj * 128 + 4 * n);
        if (u.half && u.tag) {
            float* pp = pb + (size_t)(row0 - M_LAT) * D + colt;
#pragma unroll
            for (int ai = 0; ai < 2; ++ai)
#pragma unroll
                for (int m = 0; m < 4; ++m)
#pragma unroll
                    for (int bj = 0; bj < 2; ++bj) { float* q = pp + (size_t)(ai * 128 + m * 16) * D + bj * 128;
                        f32x4 g0 = gv[bj][0], g1 = gv[bj][1]; asm volatile("" : "+v"(g0), "+v"(g1));
                        *(f32x4*)q = g0 * acc[ai][bj][m][0]; *(f32x4*)(q + 4) = g1 * acc[ai][bj][m][1]; }
            return;
        }
        bf16* sp = xb + (size_t)row0 * D + colt; float* dp = outf + (size_t)row0 * D + colt;
        const bool tof = outf != nullptr;
#pragma unroll
        for (int ai = 0; ai < 2; ++ai)
#pragma unroll
            for (int mp = 0; mp < 2; ++mp) {
                asm volatile("" : "+v"(sp), "+v"(dp) :: "memory");
                u32x4 sv[2][2];
#pragma unroll
                for (int mm = 0; mm < 2; ++mm)
#pragma unroll
                    for (int bj = 0; bj < 2; ++bj) sv[mm][bj] = *(const u32x4*)(sp + (size_t)mm * 16 * D + bj * 128);
#pragma unroll
                for (int mm = 0; mm < 2; ++mm)
#pragma unroll
                    for (int bj = 0; bj < 2; ++bj) {
                        const u32x4 s4 = sv[mm][bj];
                        f32x4 r0 = gv[bj][0] * acc[ai][bj][mp * 2 + mm][0], r1 = gv[bj][1] * acc[ai][bj][mp * 2 + mm][1];
                        r0.x += bflo(s4.x); r0.y += bfhi(s4.x); r0.z += bflo(s4.y); r0.w += bfhi(s4.y);
                        r1.x += bflo(s4.z); r1.y += bfhi(s4.z); r1.z += bflo(s4.w); r1.w += bfhi(s4.w);
                        if (tof) { *(f32x4*)(dp + (size_t)mm * 16 * D + bj * 128) = r0; *(f32x4*)(dp + (size_t)mm * 16 * D + bj * 128 + 4) = r1; }
                        else { u32x4 w; w.x = pk2(r0.x, r0.y); w.y = pk2(r0.z, r0.w); w.z = pk2(r1.x, r1.y); w.w = pk2(r1.z, r1.w); *(u32x4*)(sp + (size_t)mm * 16 * D + bj * 128) = w; }
                    }
                sp += (size_t)(mp == 1 ? 128 - 32 : 32) * D; dp += (size_t)(mp == 1 ? 128 - 32 : 32) * D;
            }
    }
};
struct EpiFfnUp {
    bf16* HID;
    __device__ __forceinline__ void operator()(const f32x4 (&acc)[2][2][4][2], const pg8::Unit& u, int wr, int wc, int fr, int fq) const {
        const int row0 = u.pm * 256 + wr * 64 + fr, col = u.pn * 128 + wc * 32 + 8 * fq;
#pragma unroll
        for (int ai = 0; ai < 2; ++ai)
#pragma unroll
            for (int m = 0; m < 4; ++m) { bf16* rowp = HID + (size_t)(row0 + ai * 128 + m * 16) * DFF + col;
                f32x4 h[2];
#pragma unroll
                for (int n = 0; n < 2; ++n) { const f32x4 g = acc[ai][0][m][n], up = acc[ai][1][m][n];
                    h[n] = (f32x4){g[0] * sigm(g[0]) * up[0], g[1] * sigm(g[1]) * up[1], g[2] * sigm(g[2]) * up[2], g[3] * sigm(g[3]) * up[3]}; }
                u32x4 w; w.x = cvt_pk(h[0][0], h[0][1]); w.y = cvt_pk(h[0][2], h[0][3]); w.z = cvt_pk(h[1][0], h[1][1]); w.w = cvt_pk(h[1][2], h[1][3]);
                *(u32x4*)rowp = w; }
    }
};

namespace pg8 {
__device__ __forceinline__ void merge_phase(LAS unsigned char* lds, const bf16* Om, const bf16* WBR, const unsigned char* GATESp, bf16* ACCp, int nM, int G, int c) {
    int tid_ = threadIdx.x; asm volatile("" : "+v"(tid_));
    const int tid = tid_, wid = __builtin_amdgcn_readfirstlane(tid >> 6), lane = tid & 63, wr = wid >> 2, wc = wid & 3, fr = lane & 15, fq = lane >> 4;
    constexpr int K = MIXW, nt = K / BK, lda = D, ldb = MIXW, nN = D / 128;
    unsigned voffA[2], voffB[2];
#pragma unroll
    for (int i = 0; i < 2; ++i) { int R, C; stage_rc(tid * 16 + i * 8192, R, C); const int Rb = (R & ~31) + perm32(R & 31);
        voffA[i] = (unsigned)(R * lda + C) * 2u; voffB[i] = (unsigned)(Rb * ldb + C) * 2u; }
    const size_t kstep = (size_t)(BK * 2);
    const size_t hstepA = (size_t)HALF * lda * 2;
    const unsigned ldsw = (unsigned)wid * 1024u;
    const int aoff = lds_byte(wr * 64 + fr, fq * 8), boff = lds_byte(wc * 32 + fr, fq * 8);
    const int ntile = nM * nN;
#define MG_SA(b, h) (((b) * 2 + (h)) * HTB)
#define MG_SB(b) ((4 + (b)) * HTB)
#define MG_STAGE(bufoff, gbase, voff) do { _Pragma("unroll") for (int _i = 0; _i < 2; ++_i) \
        __builtin_amdgcn_global_load_lds((const unsigned*)((const char*)(gbase) + (voff)[_i]), (LAS unsigned*)(lds + (bufoff) + ldsw + _i * 8192), 16, 0, 0); } while (0)
#define MG_LDA(dst, b, h) do { _Pragma("unroll") for (int m = 0; m < 4; ++m) _Pragma("unroll") for (int k = 0; k < 2; ++k) dst[m][k] = *(const LAS bf16x8*)(lds + MG_SA(b, h) + aoff + m * 2048 + k * 1024); } while (0)
#define MG_LDB(dst, b) do { _Pragma("unroll") for (int n = 0; n < 2; ++n) _Pragma("unroll") for (int k = 0; k < 2; ++k) dst[n][k] = *(const LAS bf16x8*)(lds + MG_SB(b) + boff + n * 2048 + k * 1024); } while (0)
#define MG_MMA(ai) do { __builtin_amdgcn_s_setprio(1); _Pragma("unroll") for (int m = 0; m < 4; ++m) _Pragma("unroll") for (int n = 0; n < 2; ++n) _Pragma("unroll") for (int k = 0; k < 2; ++k) \
        acc[ai][m][n] = __builtin_amdgcn_mfma_f32_16x16x32_bf16(B0[n][k], At[m][k], acc[ai][m][n], 0, 0, 0); __builtin_amdgcn_s_setprio(0); } while (0)
#define MG_WAIT_V(n) asm volatile("s_waitcnt vmcnt(" #n ")" ::: "memory")
#define MG_WAIT_L(n) asm volatile("s_waitcnt lgkmcnt(" #n ")" ::: "memory")
#define MG_BAR __builtin_amdgcn_s_barrier()
#define MG_SCHED __builtin_amdgcn_sched_barrier(0)
    int ui = 0, pm, pn, tag = 0;
    if (c >= ntile) return;
    rect_unit(c, nM, nN, pm, pn);
    f32x4 acc[2][4][2], tot[2][4][2];
#pragma unroll
    for (int a = 0; a < 2; ++a)
#pragma unroll
        for (int m = 0; m < 4; ++m)
#pragma unroll
            for (int n = 0; n < 2; ++n) { acc[a][m][n] = (f32x4){0.f, 0.f, 0.f, 0.f}; tot[a][m][n] = (f32x4){0.f, 0.f, 0.f, 0.f}; }
    bf16x8 At[4][2], B0[2][2]; u32x2 gq[2][4];
    const char* cA = (const char*)(Om + (size_t)pm * 256 * lda); const char* cB = (const char*)(WBR + (size_t)pn * 128 * ldb);
    MG_STAGE(MG_SB(0), cB, voffB); MG_STAGE(MG_SA(0, 0), cA, voffA); MG_STAGE(MG_SA(0, 1), cA + hstepA, voffA);
    if (wr == 1) MG_BAR;
    MG_WAIT_V(2); MG_BAR;
    MG_STAGE(MG_SB(1), cB + kstep, voffB); MG_STAGE(MG_SA(1, 0), cA + kstep, voffA);
    MG_WAIT_V(4); MG_BAR;
    for (;;) {
        int npm = pm, npn = pn, ntag = tag + 1; bool has_next = true;
        if (ntag == 4) { ntag = 0; const long L = (long)((ui + 1) / 4) * G + c; if (L >= ntile) has_next = false; else rect_unit((int)L, nM, nN, npm, npn); }
        const char* nA = has_next ? (const char*)(Om + (size_t)npm * 256 * lda + (size_t)ntag * MIXW) : cA;
        const char* nB = has_next ? (const char*)(WBR + (size_t)ntag * D * MIXW + (size_t)npn * 128 * ldb) : cB;
        const unsigned char* gpp = GATESp + (size_t)(pm * 256 + wr * 64 + fr) * NGATE + (size_t)tag * D + pn * 128 + wc * 32 + 8 * fq;
        asm volatile("" : "+v"(gpp));
        for (int t = 0; t < nt; t += 2) {
            const bool last = (t == nt - 2);
            const char* a1 = cA + (size_t)(t + 1) * kstep;
            const char* a2 = last ? nA : cA + (size_t)(t + 2) * kstep; const char* b2 = last ? nB : cB + (size_t)(t + 2) * kstep;
            const char* a3 = a2 + kstep; const char* b3 = b2 + kstep;
            MG_LDB(B0, 0); MG_SCHED; MG_LDA(At, 0, 0); MG_STAGE(MG_SA(1, 1), a1 + hstepA, voffA);
            MG_WAIT_V(6); MG_WAIT_L(0); MG_BAR; MG_MMA(0); MG_BAR; MG_SCHED;
            MG_LDA(At, 0, 1);
            if (t == 2) {
#pragma unroll
                for (int a = 0; a < 2; ++a)
#pragma unroll
                    for (int m = 0; m < 4; ++m) { const unsigned char* gp_ = gpp + (size_t)(a * 128 + m * 16) * NGATE;
                        asm volatile("global_load_dwordx2 %0, %1, off" : "=&v"(gq[a][m]) : "v"(gp_) : "memory"); }
            }
            MG_STAGE(MG_SB(0), b2, voffB); MG_STAGE(MG_SA(0, 0), a2, voffA);
            MG_WAIT_V(6); MG_WAIT_L(0); MG_BAR; MG_MMA(1); MG_BAR; MG_SCHED;
            MG_LDB(B0, 1); MG_SCHED; MG_LDA(At, 1, 0); MG_STAGE(MG_SA(0, 1), a2 + hstepA, voffA);
            MG_WAIT_V(6); MG_WAIT_L(0); MG_BAR; MG_MMA(0); MG_BAR; MG_SCHED;
            MG_LDA(At, 1, 1); MG_STAGE(MG_SB(1), b3, voffB); MG_STAGE(MG_SA(1, 0), a3, voffA);
            MG_WAIT_V(6); MG_WAIT_L(0); MG_BAR; MG_MMA(1); MG_BAR; MG_SCHED;
        }
        if (wr == 0) MG_BAR;
        {
            const int row0 = pm * 256 + wr * 64 + fr, col = pn * 128 + wc * 32 + 8 * fq;
#pragma unroll
            for (int a = 0; a < 2; ++a)
#pragma unroll
                for (int m = 0; m < 4; ++m) { const u32x2 g2 = gq[a][m];
                    tot[a][m][0] += acc[a][m][0] * u8x4f(g2.x);
                    tot[a][m][1] += acc[a][m][1] * u8x4f(g2.y);
                    acc[a][m][0] = (f32x4){0.f, 0.f, 0.f, 0.f}; acc[a][m][1] = (f32x4){0.f, 0.f, 0.f, 0.f}; }
            if (tag == 3) {
                bf16* ap = ACCp + (size_t)row0 * D + col;
#pragma unroll
                for (int a = 0; a < 2; ++a)
#pragma unroll
                    for (int m = 0; m < 4; ++m) { const f32x4 v0 = tot[a][m][0] * (1.0f / 255.0f), v1 = tot[a][m][1] * (1.0f / 255.0f);
                        u32x4 w; w.x = cvt_pk(v0[0], v0[1]); w.y = cvt_pk(v0[2], v0[3]); w.z = cvt_pk(v1[0], v1[1]); w.w = cvt_pk(v1[2], v1[3]);
                        *(u32x4*)(ap + (size_t)(a * 128 + m * 16) * D) = w;
                        tot[a][m][0] = (f32x4){0.f, 0.f, 0.f, 0.f}; tot[a][m][1] = (f32x4){0.f, 0.f, 0.f, 0.f}; }
            }
        }
        if (!has_next) break;
        pm = npm; pn = npn; tag = ntag; cA = nA; cB = nB; ++ui;
        if (wr == 1) MG_BAR;
    }
    MG_WAIT_V(0);
    MG_BAR;
#undef MG_SA
#undef MG_SB
#undef MG_STAGE
#undef MG_LDA
#undef MG_LDB
#undef MG_MMA
#undef MG_WAIT_V
#undef MG_WAIT_L
#undef MG_BAR
#undef MG_SCHED
}
}

__device__ __forceinline__ float wave_sum(float v) {
#pragma unroll
    for (int o = 1; o < 64; o <<= 1) v += __shfl_xor(v, o);
    return v;
}
__device__ __forceinline__ void transpose_item(const float* W, int N, bf16* WT, int ldt, int k0, int n0, int drow0, LAS float* scr, int lane) {
    const int rr = lane >> 3, c4 = lane & 7;
    f32x4 v[8];
#pragma unroll
    for (int i = 0; i < 8; ++i) v[i] = *(const f32x4*)(W + (size_t)(k0 + 8 * i + rr) * N + n0 + 4 * c4);
#pragma unroll
    for (int i = 0; i < 8; ++i) { LAS float* sp = scr + (8 * i + rr) * 33 + 4 * c4; sp[0] = v[i].x; sp[1] = v[i].y; sp[2] = v[i].z; sp[3] = v[i].w; }
    LDS_WAIT(); asm volatile("" ::: "memory");
    const int c = lane & 7;
#pragma unroll
    for (int j = 0; j < 4; ++j) { const int n = (lane >> 3) + 8 * j; const LAS float* s = scr + (8 * c) * 33 + n;
        v4u o; o.x = pk2(s[0 * 33], s[1 * 33]); o.y = pk2(s[2 * 33], s[3 * 33]); o.z = pk2(s[4 * 33], s[5 * 33]); o.w = pk2(s[6 * 33], s[7 * 33]);
        *(GAS v4u*)(WT + (size_t)(drow0 + n) * ldt + k0 + 8 * c) = o; }
    LDS_WAIT(); asm volatile("" ::: "memory");
}

typedef float f32x16 __attribute__((ext_vector_type(16)));
typedef short s16x4 __attribute__((ext_vector_type(4)));
typedef unsigned v2u __attribute__((ext_vector_type(2)));
typedef __bf16 bf16x2_t __attribute__((ext_vector_type(2)));
typedef float f32x2_t __attribute__((ext_vector_type(2)));
#define MFMA32(a, b, c) __builtin_amdgcn_mfma_f32_32x32x16_bf16((a), (b), (c), 0, 0, 0)
__device__ __forceinline__ unsigned cvtpk_s(float lo, float hi) { f32x2_t v = {lo, hi}; bf16x2_t b = __builtin_convertvector(v, bf16x2_t); return __builtin_bit_cast(unsigned, b); }
constexpr float L2E = 1.4426950408889634f, NEG_BIG = -1e30f, RESC_THR = 8.0f;
constexpr int AT_STAGE = 36864, AT_VOFF = 16384;
constexpr int VC_A = 0, VC_B = MIXW, VC_S = 2 * MIXW, NVC = 2 * MIXW + SKV * HDIM;

__device__ __forceinline__ float xhalf_max(float x) { const unsigned u = __builtin_bit_cast(unsigned, x); auto r = __builtin_amdgcn_permlane32_swap(u, u, false, false); return fmaxf(__builtin_bit_cast(float, r[0]), __builtin_bit_cast(float, r[1])); }
__device__ __forceinline__ float xhalf_sum(float x) { const unsigned u = __builtin_bit_cast(unsigned, x); auto r = __builtin_amdgcn_permlane32_swap(u, u, false, false); return __builtin_bit_cast(float, r[0]) + __builtin_bit_cast(float, r[1]); }
template <int NK, int DV> struct StageRegs { v4u k[NK]; v4u v[DV / 64]; };
typedef short v4i16_t __attribute__((ext_vector_type(4)));
template <int NK, int DV>
__device__ __forceinline__ void at_load(StageRegs<NK, DV>& R, const bf16* QKV, int tok0, int kcol, int vcol, int tid) {
    const int row = tid >> 3, c = tid & 7; const bf16* rp = QKV + (size_t)(tok0 + row) * NQKV + 8 * c;
#pragma unroll
    for (int ki = 0; ki < NK; ++ki) R.k[ki] = *(const v4u*)(rp + kcol + 64 * ki);
#pragma unroll
    for (int vi = 0; vi < DV / 64; ++vi) R.v[vi] = *(const v4u*)(rp + vcol + 64 * vi);
}
template <int NK, int DV>
__device__ __forceinline__ void at_write(LAS unsigned char* buf, const StageRegs<NK, DV>& R, int tid) {
    const int row = tid >> 3, c = tid & 7;
#pragma unroll
    for (int ki = 0; ki < NK; ++ki) *(LAS v4u*)(buf + ki * 8192 + (row * 8 + (c ^ ((row >> 1) & 7))) * 16) = R.k[ki];
#pragma unroll
    for (int vi = 0; vi < DV / 64; ++vi) *(LAS v4u*)(buf + AT_VOFF + row * (2 * DV + 64) + (vi * 8 + c) * 16) = R.v[vi];
}
template <int DV>
__device__ __forceinline__ void at_lane_offsets(int lane, int& koff, int& voff) { const int r = lane & 31, hh = lane >> 5; koff = r * 128 + ((hh ^ ((r >> 1) & 7)) * 16);
    voff = (((lane & 15) >> 2) + 4 * hh) * (2 * DV + 64) + 32 * ((lane >> 4) & 1) + 8 * (lane & 3); }
template <int DV, int MODE>
__device__ __forceinline__ void at_compute(const LAS unsigned char* buf, int kidx, const bf16x8 (&Qf)[4], f32x16 (&Oa)[DV / 32], float& m, float& l, f32x16& negm, int lane, int koff, int voff, bool masked, int qpos, int kpos0, const float* bias) {
    const int hh = lane >> 5;
    f32x16 s0 = negm, s1 = negm;
    const LAS unsigned char* kb = buf + kidx * 8192;
#pragma unroll
    for (int ks = 0; ks < 4; ++ks) {
        const bf16x8 k0 = *(const LAS bf16x8*)(kb + (koff ^ (32 * ks)));
        const bf16x8 k1 = *(const LAS bf16x8*)(kb + 4096 + (koff ^ (32 * ks)));
        s0 = MFMA32(k0, Qf[ks], s0); s1 = MFMA32(k1, Qf[ks], s1); }
    if (MODE == 1) { if (masked) {
        int cs = qpos - NAC / 2; cs = cs < 0 ? 0 : (cs > GW - NAC ? GW - NAC : cs);
        const int vofs = 4 * hh - cs; const LAS unsigned char* tb = (const LAS unsigned char*)(size_t)0 + kpos0;
#pragma unroll
        for (int i = 0; i < 16; ++i) { const int c0 = (i & 3) + 8 * (i >> 2), c1 = c0 + 32;
            const float b0 = *(const LAS float*)(tb + 4 * c0), b1 = *(const LAS float*)(tb + 4 * c1);
            s0[i] = ((unsigned)(c0 + vofs) < (unsigned)NAC) ? s0[i] + b0 : NEG_BIG; s1[i] = ((unsigned)(c1 + vofs) < (unsigned)NAC) ? s1[i] + b1 : NEG_BIG; } } }
    if (MODE == 2) { if (masked) {
#pragma unroll
        for (int i = 0; i < 16; ++i) { const int d0 = kpos0 + (i & 3) + 8 * (i >> 2) + 4 * hh - qpos, d1 = d0 + 32;
            s0[i] = (d0 >= -SWW && d0 <= SWW) ? s0[i] : NEG_BIG; s1[i] = (d1 >= -SWW && d1 <= SWW) ? s1[i] : NEG_BIG; } } }
    const LAS unsigned char* vb = buf + AT_VOFF + voff;
    constexpr int VP = 2 * DV + 64;
#define AT_VTR(off) __builtin_bit_cast(s16x4, __builtin_amdgcn_ds_read_tr16_b64_v4i16((LAS v4i16_t*)(vb + (off))))
    s16x4 vlo[DV / 32], vhi[DV / 32];
#pragma unroll
    for (int b = 0; b < DV / 32; ++b) { vlo[b] = AT_VTR(64 * b); vhi[b] = AT_VTR(8 * VP + 64 * b); }
    __builtin_amdgcn_sched_barrier(0);
    float tmax = fmaxf(fmaxf(s0[0], s1[0]), s0[1]);
#pragma unroll
    for (int i = 1; i < 16; ++i) tmax = i == 1 ? fmaxf(tmax, s1[1]) : fmaxf(fmaxf(tmax, s0[i]), s1[i]);
    if (__any(tmax > RESC_THR)) {
        tmax = fmaxf(tmax, __shfl_xor(tmax, 32));
        const float d = fmaxf(tmax, 0.f), corr = __builtin_amdgcn_exp2f(-d);
        m += d; l *= corr;
#pragma unroll
        for (int b = 0; b < DV / 32; ++b) Oa[b] *= corr;
        s0 -= d; s1 -= d;
        const float nm = -m;
#pragma unroll
        for (int i = 0; i < 16; ++i) negm[i] = nm;
    }
#pragma unroll
    for (int i = 0; i < 16; ++i) { s0[i] = __builtin_amdgcn_exp2f(s0[i]); s1[i] = __builtin_amdgcn_exp2f(s1[i]); }
    { const f32x16 pp = s0 + s1; const f32x4 q4 = (f32x4){pp[0], pp[1], pp[2], pp[3]} + (f32x4){pp[4], pp[5], pp[6], pp[7]} + (f32x4){pp[8], pp[9], pp[10], pp[11]} + (f32x4){pp[12], pp[13], pp[14], pp[15]};
      l += (q4.x + q4.y) + (q4.z + q4.w); }
#pragma unroll
    for (int st = 0; st < 4; ++st) {
        const int sub = st >> 1, s = st & 1;
        u32x4 pk;
        if (sub == 0) { pk.x = cvtpk_s(s0[8 * s + 0], s0[8 * s + 1]); pk.y = cvtpk_s(s0[8 * s + 2], s0[8 * s + 3]); pk.z = cvtpk_s(s0[8 * s + 4], s0[8 * s + 5]); pk.w = cvtpk_s(s0[8 * s + 6], s0[8 * s + 7]); }
        else { pk.x = cvtpk_s(s1[8 * s + 0], s1[8 * s + 1]); pk.y = cvtpk_s(s1[8 * s + 2], s1[8 * s + 3]); pk.z = cvtpk_s(s1[8 * s + 4], s1[8 * s + 5]); pk.w = cvtpk_s(s1[8 * s + 6], s1[8 * s + 7]); }
        const bf16x8 pb = __builtin_bit_cast(bf16x8, pk);
        s16x4 nlo[DV / 32], nhi[DV / 32];
        if (st < 3) { const int k0 = 32 * ((st + 1) >> 1) + 16 * ((st + 1) & 1);
#pragma unroll
            for (int b = 0; b < DV / 32; ++b) { nlo[b] = AT_VTR(k0 * VP + 64 * b); nhi[b] = AT_VTR((k0 + 8) * VP + 64 * b); } }
        __builtin_amdgcn_sched_barrier(0);
#pragma unroll
        for (int b = 0; b < DV / 32; ++b) { const bf16x8 vf = __builtin_shufflevector(vlo[b], vhi[b], 0, 1, 2, 3, 4, 5, 6, 7); Oa[b] = MFMA32(vf, pb, Oa[b]); }
        if (st < 3) {
#pragma unroll
            for (int b = 0; b < DV / 32; ++b) { vlo[b] = nlo[b]; vhi[b] = nhi[b]; } }
    }
#undef AT_VTR
}
template <int DV>
__device__ __forceinline__ void at_store(bf16* orow, const f32x16 (&Oa)[DV / 32], float sc, int hh) {
#pragma unroll
    for (int b = 0; b < DV / 32; ++b)
#pragma unroll
        for (int g = 0; g < 4; ++g) { v2u o; o.x = cvtpk_s(Oa[b][4 * g] * sc, Oa[b][4 * g + 1] * sc); o.y = cvtpk_s(Oa[b][4 * g + 2] * sc, Oa[b][4 * g + 3] * sc);
            *(v2u*)(orow + 32 * b + 8 * g + 4 * hh) = o; }
}
__device__ __forceinline__ void at_loadq(bf16x8 (&Qf)[4], const bf16* qp, const float* gain, bool rope, int t, const F2* RT, int hh) {
    float x[4][8]; float ss = 0.f;
#pragma unroll
    for (int ks = 0; ks < 4; ++ks) { const v4u v = *(const v4u*)(qp + 16 * ks);
        x[ks][0] = bflo(v.x); x[ks][1] = bfhi(v.x); x[ks][2] = bflo(v.y); x[ks][3] = bfhi(v.y); x[ks][4] = bflo(v.z); x[ks][5] = bfhi(v.z); x[ks][6] = bflo(v.w); x[ks][7] = bfhi(v.w);
#pragma unroll
        for (int j = 0; j < 8; ++j) ss += x[ks][j] * x[ks][j]; }
    ss += __shfl_xor(ss, 32);
    const float r = 1.0f / sqrtf(ss * (1.f / 64.f) + NORM_EPS);
#pragma unroll
    for (int ks = 0; ks < 4; ++ks) { const f32x4 g0 = *(const f32x4*)(gain + 16 * ks + 8 * hh), g1 = *(const f32x4*)(gain + 16 * ks + 8 * hh + 4);
        x[ks][0] *= r * g0.x; x[ks][1] *= r * g0.y; x[ks][2] *= r * g0.z; x[ks][3] *= r * g0.w; x[ks][4] *= r * g1.x; x[ks][5] *= r * g1.y; x[ks][6] *= r * g1.z; x[ks][7] *= r * g1.w; }
    if (rope) {
#pragma unroll
        for (int p = 0; p < 2; ++p) { const int pos = p == 0 ? t / GW : t % GW;
#pragma unroll
            for (int j = 0; j < 8; ++j) { const F2 cs = RT[pos * 16 + 8 * hh + j]; const float a = x[2 * p][j], b2 = x[2 * p + 1][j];
                x[2 * p][j] = a * cs.x - b2 * cs.y; x[2 * p + 1][j] = b2 * cs.x + a * cs.y; } } }
    constexpr float QS = 0.125f * L2E;
#pragma unroll
    for (int ks = 0; ks < 4; ++ks) { u32x4 w; w.x = pk2(x[ks][0] * QS, x[ks][1] * QS); w.y = pk2(x[ks][2] * QS, x[ks][3] * QS); w.z = pk2(x[ks][4] * QS, x[ks][5] * QS); w.w = pk2(x[ks][6] * QS, x[ks][7] * QS);
        Qf[ks] = __builtin_bit_cast(bf16x8, w); }
}

template <bool CTXQ>
__device__ __forceinline__ void attn_diff_unit(LAS unsigned char* lds, const bf16* QKV, const bf16* VT, bf16* O, int b, int h, int qb, float lam, float lam_init, const float* subln, const float* qgain, const F2* RT, int tid, int wave, int lane) {
    asm volatile("" : "+v"(tid), "+v"(lane));
    int koff, voff; at_lane_offsets<128>(lane, koff, voff);
    const int r = lane & 31, hh = lane >> 5, qg = wave & 3, ih = wave >> 2;
    __builtin_amdgcn_sched_barrier(0);
    const int mq = (CTXQ ? M_LAT + b * CL : b * S) + qb * 128 + 32 * qg + r;
    bf16x8 Qf[4]; at_loadq(Qf, QKV + (size_t)mq * NQKV + C_BQ + 64 * (2 * h + ih) + 8 * hh, qgain, !CTXQ, qb * 128 + 32 * qg + r, RT, hh);
    f32x16 Oa[4];
#pragma unroll
    for (int bb = 0; bb < 4; ++bb)
#pragma unroll
        for (int i = 0; i < 16; ++i) Oa[bb][i] = 0.f;
    float m = 0.f, l = 0.f; f32x16 negm;
#pragma unroll
    for (int i = 0; i < 16; ++i) negm[i] = 0.f;
    constexpr int NLT = CTXQ ? 0 : S / 64, NT = NLT + CL / 64;
    const int kcol = C_BK + 128 * h, vcol = C_BV + 128 * h;
    StageRegs<2, 128> R;
    __syncthreads();
    at_load<2, 128>(R, QKV, NLT > 0 ? b * S : M_LAT + b * CL, kcol, vcol, tid);
    at_write<2, 128>(lds, R, tid);
    __syncthreads();
    for (int j = 0; j < NT; ++j) {
        if (j + 1 < NT) { const int jn = j + 1; at_load<2, 128>(R, QKV, jn < NLT ? b * S + 64 * jn : M_LAT + b * CL + 64 * (jn - NLT), kcol, vcol, tid); }
        at_compute<128, 0>(lds + (j & 1) * AT_STAGE, ih, Qf, Oa, m, l, negm, lane, koff, voff, false, 0, 0, nullptr);
        if (j + 1 < NT) at_write<2, 128>(lds + ((j + 1) & 1) * AT_STAGE, R, tid);
        __syncthreads();
    }
    const float lt = l + __shfl_xor(l, 32), inv = 1.0f / lt;
    LAS float* ex = (LAS float*)lds + (size_t)qg * 4096;
    if (ih == 1) {
#pragma unroll
        for (int bb = 0; bb < 4; ++bb)
#pragma unroll
            for (int i = 0; i < 16; ++i) ex[(bb * 16 + i) * 64 + lane] = Oa[bb][i] * inv * lam;
    }
    __syncthreads();
    if (ih == 0) {
        float ss = 0.f;
#pragma unroll
        for (int bb = 0; bb < 4; ++bb)
#pragma unroll
            for (int i = 0; i < 16; ++i) { const float v = Oa[bb][i] * inv - ex[(bb * 16 + i) * 64 + lane]; Oa[bb][i] = v; ss += v * v; }
        ss += __shfl_xor(ss, 32);
        const float rs = (1.0f / sqrtf(ss * (1.0f / 128.0f) + NORM_EPS)) * (1.0f - lam_init);
#pragma unroll
        for (int bb = 0; bb < 4; ++bb)
#pragma unroll
            for (int g = 0; g < 4; ++g) { const f32x4 sg = *(const f32x4*)(subln + 32 * bb + 8 * g + 4 * hh);
                Oa[bb][4 * g] *= sg.x; Oa[bb][4 * g + 1] *= sg.y; Oa[bb][4 * g + 2] *= sg.z; Oa[bb][4 * g + 3] *= sg.w; }
        at_store<128>(O + (size_t)mq * D + MIXW + 128 * h, Oa, rs, hh);
    }
}
template <bool CTXQ>
__device__ __forceinline__ void attn_swa_unit(LAS unsigned char* lds, const bf16* QKV, const bf16* VT, bf16* O, int b, int kvh, int qb, const float* sink, const float* qgain, const F2* RT, int tid, int wave, int lane) {
    asm volatile("" : "+v"(tid), "+v"(lane));
    int koff, voff; at_lane_offsets<64>(lane, koff, voff);
    const int r = lane & 31, hh = lane >> 5, qg = wave & 1, hq = kvh * SG + (wave >> 1);
    const int q0 = qb * 64, tq = q0 + 32 * qg + r;
    const int mq = (CTXQ ? M_LAT + b * CL : b * S) + tq;
    bf16x8 Qf[4]; at_loadq(Qf, QKV + (size_t)mq * NQKV + C_SQ + 64 * hq + 8 * hh, qgain, !CTXQ, tq, RT, hh);
    f32x16 Oa[2];
#pragma unroll
    for (int bb = 0; bb < 2; ++bb)
#pragma unroll
        for (int i = 0; i < 16; ++i) Oa[bb][i] = 0.f;
    float m = 0.f, l = 0.f; f32x16 negm;
#pragma unroll
    for (int i = 0; i < 16; ++i) negm[i] = 0.f;
    int jlo = 0, nlat = 0;
    if (!CTXQ) { jlo = q0 >= SWW ? 0 : (SWW - q0) / 64; int jhi = (S + SWW - q0) / 64; if (jhi > 5) jhi = 5; nlat = jhi - jlo; }
    const int NT = nlat + CL / 64;
    const int kcol = C_SK + 64 * kvh, vcol = C_SV + 64 * kvh;
    StageRegs<1, 64> R;
    __syncthreads();
    at_load<1, 64>(R, QKV, nlat > 0 ? b * S + q0 - SWW + 64 * jlo : M_LAT + b * CL, kcol, vcol, tid);
    at_write<1, 64>(lds, R, tid);
    __syncthreads();
    for (int j = 0; j < NT; ++j) {
        if (j + 1 < NT) { const int jn = j + 1; at_load<1, 64>(R, QKV, jn < nlat ? b * S + q0 - SWW + 64 * (jlo + jn) : M_LAT + b * CL + 64 * (jn - nlat), kcol, vcol, tid); }
        at_compute<64, 2>(lds + (j & 1) * AT_STAGE, 0, Qf, Oa, m, l, negm, lane, koff, voff, j < nlat && (jlo + j == 0 || jlo + j == 4), tq, q0 - SWW + 64 * (jlo + j), nullptr);
        if (j + 1 < NT) at_write<1, 64>(lds + ((j + 1) & 1) * AT_STAGE, R, tid);
        __syncthreads();
    }
    float lt = l + __shfl_xor(l, 32);
    const float sk = sink[hq] * L2E, mnew = fmaxf(m, sk), corr = __builtin_amdgcn_exp2f(m - mnew);
    lt = lt * corr + __builtin_amdgcn_exp2f(sk - mnew);
    at_store<64>(O + (size_t)mq * D + 2 * MIXW + 64 * hq, Oa, corr / lt, hh);
}
template <bool CTXQ>
__device__ __forceinline__ void attn_na_unit(LAS unsigned char* lds, const bf16* QKV, const bf16* VT, bf16* O, int b, int head, int rg, const float* rpb, const float* qgain, const F2* RT, int tid, int wave, int lane) {
    asm volatile("" : "+v"(tid), "+v"(lane));
    int koff, voff; at_lane_offsets<64>(lane, koff, voff);
    const int r = lane & 31, hh = lane >> 5, qg = wave & 1, gr = 4 * rg + (wave >> 1);
    const int qc = 32 * qg + r;
    const int mq = (CTXQ ? M_LAT + b * CL : b * S) + gr * GW + qc;
    bf16x8 Qf[4]; at_loadq(Qf, QKV + (size_t)mq * NQKV + C_AQ + 64 * head + 8 * hh, qgain, false, 0, RT, hh);
    f32x16 Oa[2];
#pragma unroll
    for (int bb = 0; bb < 2; ++bb)
#pragma unroll
        for (int i = 0; i < 16; ++i) Oa[bb][i] = 0.f;
    float m = 0.f, l = 0.f; f32x16 negm;
#pragma unroll
    for (int i = 0; i < 16; ++i) negm[i] = 0.f;
    int klo = 0, nlat = 0, rsw = 0;
    if (!CTXQ) { klo = 4 * rg - NAR / 2; klo = klo < 0 ? 0 : (klo > ROWS - NAR ? ROWS - NAR : klo); int kl3 = 4 * rg + 3 - NAR / 2; kl3 = kl3 < 0 ? 0 : (kl3 > ROWS - NAR ? ROWS - NAR : kl3); nlat = kl3 + NAR - klo;
        rsw = gr - NAR / 2; rsw = rsw < 0 ? 0 : (rsw > ROWS - NAR ? ROWS - NAR : rsw); }
    const int NT = nlat + CL / 64;
    const int kcol = C_AK + 64 * head, vcol = C_AV + 64 * head;
    StageRegs<1, 64> R;
    constexpr int NA_TBL = 73728, NA_TROW = 132;
    static_assert(2 * AT_STAGE <= NA_TBL && NA_TBL + (2 * NAR - 1) * NA_TROW * 4 <= RING_BYTES, "NA bias table");
    __syncthreads();
    if (!CTXQ) for (int i = tid; i < (2 * NAR - 1) * (2 * NAC - 1); i += NTHR) { const int dr_ = i / (2 * NAC - 1), ix_ = i - dr_ * (2 * NAC - 1);
        *(LAS float*)(lds + NA_TBL + (dr_ * NA_TROW + 48 + ix_) * 4) = rpb[head * (2 * NAR - 1) * (2 * NAC - 1) + i] * L2E; }
    const int btl = NA_TBL + (15 + 4 * hh - qc + 48) * 4;
    at_load<1, 64>(R, QKV, nlat > 0 ? b * S + klo * GW : M_LAT + b * CL, kcol, vcol, tid);
    at_write<1, 64>(lds, R, tid);
    __syncthreads();
    for (int j = 0; j < NT; ++j) {
        if (j + 1 < NT) { const int jn = j + 1; at_load<1, 64>(R, QKV, jn < nlat ? b * S + (klo + jn) * GW : M_LAT + b * CL + 64 * (jn - nlat), kcol, vcol, tid); }
        const int kr = klo + j; const bool lat = j < nlat;
        if (!lat || (kr >= rsw && kr < rsw + NAR))
            at_compute<64, 1>(lds + (j & 1) * AT_STAGE, 0, Qf, Oa, m, l, negm, lane, koff, voff, lat, qc, (int)(size_t)lds + btl + (kr - gr + NAR - 1) * NA_TROW * 4, nullptr);
        if (j + 1 < NT) at_write<1, 64>(lds + ((j + 1) & 1) * AT_STAGE, R, tid);
        __syncthreads();
    }
    const float lt = l + __shfl_xor(l, 32);
    at_store<64>(O + (size_t)mq * D + 64 * head, Oa, 1.0f / lt, hh);
}
__device__ __forceinline__ void vt_items4(LAS unsigned char* lds, const bf16* QKV, bf16* VT, int it0, int nit, int tid) {
    constexpr int NCT = NVC / 64;
    const int tok = tid >> 3, c8 = tid & 7;
    v4u v[4];
#pragma unroll
    for (int q = 0; q < 4; ++q) { const int it = it0 + q; v[q] = (v4u){0u, 0u, 0u, 0u};
        if (it < nit) { const int tt = it / NCT, ct = it % NCT; const int scol = ct < MIXW / 64 ? C_AV + 64 * ct : (ct < 2 * MIXW / 64 ? C_BV + 64 * (ct - MIXW / 64) : C_SV + 64 * (ct - 2 * MIXW / 64));
            v[q] = *(const v4u*)(QKV + (size_t)(tt * 64 + tok) * NQKV + scol + 8 * c8); } }
    __syncthreads();
#pragma unroll
    for (int q = 0; q < 4; ++q) { LAS unsigned short* T = (LAS unsigned short*)(lds + q * 9216) + (tok ^ (8 * c8));
        T[(8 * c8 + 0) * 72] = (unsigned short)(v[q].x & 0xffffu); T[(8 * c8 + 1) * 72] = (unsigned short)(v[q].x >> 16);
        T[(8 * c8 + 2) * 72] = (unsigned short)(v[q].y & 0xffffu); T[(8 * c8 + 3) * 72] = (unsigned short)(v[q].y >> 16);
        T[(8 * c8 + 4) * 72] = (unsigned short)(v[q].z & 0xffffu); T[(8 * c8 + 5) * 72] = (unsigned short)(v[q].z >> 16);
        T[(8 * c8 + 6) * 72] = (unsigned short)(v[q].w & 0xffffu); T[(8 * c8 + 7) * 72] = (unsigned short)(v[q].w >> 16); }
    __syncthreads();
    const int ch = tid >> 3, c = tid & 7;
#pragma unroll
    for (int q = 0; q < 4; ++q) { const int it = it0 + q;
        if (it < nit) { const int tt = it / NCT, ct = it % NCT;
            const v4u o = *(const LAS v4u*)(lds + q * 9216 + ch * 144 + ((c ^ (ch >> 3)) * 16));
            *(v4u*)(VT + (size_t)(ct * 64 + ch) * MT + tt * 64 + 8 * c) = o; } }
}
__device__ __forceinline__ void prep_geom(int gi, int& col0, int& ns) {
    if (gi == 0) { col0 = C_AQ; ns = NAH; } else if (gi == 1) { col0 = C_AK; ns = NAH; } else if (gi == 2) { col0 = C_BQ; ns = 2 * DFH; }
    else if (gi == 3) { col0 = C_BK; ns = 2 * DFH; } else if (gi == 4) { col0 = C_SQ; ns = SWH; } else { col0 = C_SK; ns = SKV; }
}
__device__ __forceinline__ v4u prep_load(const bf16* QKV, int m, int gi, int lane) {
    int col0, ns; prep_geom(gi, col0, ns);
    const int sl = lane >> 3, part = lane & 7;
    v4u v = (v4u){0u, 0u, 0u, 0u}; if (sl < ns) v = *(const v4u*)(QKV + (size_t)m * NQKV + col0 + 64 * sl + 8 * part);
    return v;
}
__device__ __forceinline__ void prep_finish(bf16* QKV, v4u v, int m, int gi, const LayerP& P, const F2* RT, int lane) {
    int col0, ns; prep_geom(gi, col0, ns);
    const float* g = gi == 0 ? P.aqn : gi == 1 ? P.akn : gi == 2 ? P.bqn : gi == 3 ? P.bkn : gi == 4 ? P.cqn : P.ckn;
    const bool isq = (gi == 0 || gi == 2 || gi == 4), rope = gi >= 2;
    const int sl = lane >> 3, part = lane & 7; const bool act = sl < ns;
    bool isctx; int b, t; row_decode(m, isctx, b, t);
    bf16* p = QKV + (size_t)m * NQKV + col0 + 64 * sl + 8 * part;
    float x[8] = {bflo(v.x), bfhi(v.x), bflo(v.y), bfhi(v.y), bflo(v.z), bfhi(v.z), bflo(v.w), bfhi(v.w)};
    float ss = 0.f;
#pragma unroll
    for (int i = 0; i < 8; ++i) ss += x[i] * x[i];
    ss += __shfl_xor(ss, 1); ss += __shfl_xor(ss, 2); ss += __shfl_xor(ss, 4);
    const float r = 1.0f / sqrtf(ss * (1.f / 64.f) + NORM_EPS);
    const f32x4 g0 = *(const f32x4*)(g + 8 * part), g1 = *(const f32x4*)(g + 8 * part + 4);
    x[0] *= r * g0.x; x[1] *= r * g0.y; x[2] *= r * g0.z; x[3] *= r * g0.w; x[4] *= r * g1.x; x[5] *= r * g1.y; x[6] *= r * g1.z; x[7] *= r * g1.w;
    if (rope && !isctx) {
        const int pos = (part >> 2) ? t % GW : t / GW; const bool hi = (part & 2) != 0; const int fb = 8 * (part & 1);
#pragma unroll
        for (int i = 0; i < 8; ++i) { const float o = __shfl_xor(x[i], 2); const F2 cs = RT[pos * 16 + fb + i]; x[i] = hi ? x[i] * cs.x + o * cs.y : x[i] * cs.x - o * cs.y; }
    }
    const float sc = isq ? 0.125f : 1.0f;
    v4u w; w.x = pk2(x[0] * sc, x[1] * sc); w.y = pk2(x[2] * sc, x[3] * sc); w.z = pk2(x[4] * sc, x[5] * sc); w.w = pk2(x[6] * sc, x[7] * sc);
    if (act) *(v4u*)p = w;
}
template <int W>
__device__ __forceinline__ void pool_d_w(const bf16* QKV, bf16* OUT, int ldo, int m, int c8) {
    bool isctx; int b, t; row_decode(m, isctx, b, t);
    const int T = isctx ? CL : S, ch = c8 * 8, lo = t - W / 2;
    const bf16* base = QKV + (size_t)(m - t) * NQKV + C_DU + ch;
    v4u v[W];
#pragma unroll
    for (int j = 0; j < W; ++j) { int jj = lo + j; jj = jj < 0 ? 0 : (jj > T - 1 ? T - 1 : jj); v[j] = *(const v4u*)(base + (size_t)jj * NQKV); }
    float sum[8] = {0.f, 0.f, 0.f, 0.f, 0.f, 0.f, 0.f, 0.f}; int cnt = 0;
#pragma unroll
    for (int j = 0; j < W; ++j) { const int jj = lo + j; const bool ok = jj >= 0 && jj < T; const float f = ok ? 1.0f : 0.0f; cnt += ok ? 1 : 0;
        sum[0] += f * bflo(v[j].x); sum[1] += f * bfhi(v[j].x); sum[2] += f * bflo(v[j].y); sum[3] += f * bfhi(v[j].y); sum[4] += f * bflo(v[j].z); sum[5] += f * bfhi(v[j].z); sum[6] += f * bflo(v[j].w); sum[7] += f * bfhi(v[j].w); }
    const float inv = 1.0f / (float)cnt; const v4u u = v[W / 2];
    v4u o; o.x = pk2(sum[0] * inv - bflo(u.x), sum[1] * inv - bfhi(u.x)); o.y = pk2(sum[2] * inv - bflo(u.y), sum[3] * inv - bfhi(u.y));
    o.z = pk2(sum[4] * inv - bflo(u.z), sum[5] * inv - bfhi(u.z)); o.w = pk2(sum[6] * inv - bflo(u.w), sum[7] * inv - bfhi(u.w));
    *(v4u*)(OUT + (size_t)m * ldo + ch) = o;
}
__device__ __forceinline__ int launder_i(int i) { asm volatile("" : "+s"(i)); return i; }
struct Args { const float* in[29]; float* out; unsigned char* ws; int ph_lo, ph_hi; };
static_assert(sizeof(Args) == 29 * 8 + 8 + 8 + 8, "Args has no padding");

enum { I_X = 0, I_C, I_CTX, I_CCTX, I_WADA, I_BADA, I_NMIX, I_NFFN, I_WIN, I_AQN, I_AKN, I_RPB, I_BQN, I_BKN, I_LQ1, I_LK1, I_LQ2, I_LK2, I_SUBLN, I_CQN, I_CKN, I_SINK, I_DW, I_DSCALE, I_WBR, I_WOUT, I_WG, I_WU, I_WD };
constexpr int NPRO = 2, NPL = 9, NPHASE = NPRO + NL * NPL;

__global__ void __launch_bounds__(NTHR, 2) mega(Args args) {
    extern __shared__ __attribute__((aligned(16))) unsigned char lds_raw[];
    LAS unsigned char* lds = (LAS unsigned char*)lds_raw;
    const int tid = threadIdx.x, lane0 = tid & 63, wave = __builtin_amdgcn_readfirstlane(tid >> 6);
    const int G = gridDim.x, bx = blockIdx.x;
    const int gw = bx * NWAVES + wave, NGW = G * NWAVES;
    const long gt0 = (long)bx * NTHR + tid, NGT = (long)G * NTHR;
    unsigned char* ws = args.ws;
    unsigned* ctl = (unsigned*)(ws + WS_CTL);
    float* CACT = (float*)(ws + WS_MISC + MISC_CACT); F2* RT = (F2*)(ws + WS_MISC + MISC_RT); float* LAM = (float*)(ws + WS_MISC + MISC_LAM); float* KG = (float*)(ws + WS_MISC + MISC_LAM + 64);
    float* MODV = (float*)(ws + WS_MODV); float* CTXR = (float*)(ws + WS_CTXR);
    bf16* WIN_T = (bf16*)(ws + WS_WIN);
    bf16* H = (bf16*)(ws + WS_H); float* OB = (float*)(ws + WS_H); bf16* QKV = (bf16*)(ws + WS_QKV); bf16* ACC = (bf16*)(ws + WS_QKV);
    unsigned char* GATES = ws + WS_GATES; bf16* HID = (bf16*)(ws + WS_GATES); bf16* DPOOL = (bf16*)(ws + WS_DPOOL); bf16* O = (bf16*)(ws + WS_O);
    u32x4* TMP = (u32x4*)(ws + WS_TMP) + (size_t)bx * (256 * 256 / 8); bf16* VT = (bf16*)(ws + WS_VT);
    bf16* XB = (bf16*)(ws + WS_XB); float* PB = (float*)(ws + WS_CTXR);

    for (int u = tid; u < (LDS_BYTES - LDSCTL_OFF) / 4; u += NTHR) ((LAS unsigned*)(lds + LDSCTL_OFF))[u] = 0u;
    __syncthreads();
    const int lo = args.ph_lo, hi = args.ph_hi;
    XcdBarrier bar; bar.bar = ctl + CW_BAR; bar.x = 0; bar.st = nullptr;
    if (hi - lo > 1) bar = xcd_barrier_post(ctl + CW_BAR, (volatile LAS unsigned*)(lds + MISC_OFF) + 8);
#define IN(k) (lo <= (k) && (k) < hi)
#define AIN(i) (args.in[launder_i(i)])
#define SEAM(k) do { if (IN(k) && IN((k) + 1)) xcd_barrier(bar); } while (0)

    constexpr int I_IN = (D / 64) * (PROJW / 32), I_BR = (MIXW / 64) * (D / 32), I_OUT = (D / 64) * (D / 32), I_GU = (D / 64) * (DFF / 32), I_DN = (DFF / 64) * (D / 32);
    constexpr int NIT = I_IN + 3 * I_BR + I_OUT + 2 * I_GU + I_DN;
#define CONV_ITEM(it_, LL, WBRp, WOUTp, WGUp, WDp) do { int r = (it_); \
            if (r < I_IN) { const int nb = PROJW / 32, kb = r / nb, n0 = (r % nb) * 32; transpose_item(AIN(I_WIN) + (size_t)(LL) * D * PROJW, PROJW, WIN_T, D, kb * 64, n0, kperm_row(n0), scr, lane); break; } r -= I_IN; \
            if (r < 3 * I_BR) { const int n = r / I_BR, rr = r % I_BR, nb = D / 32, kb = rr / nb, n0 = (rr % nb) * 32; \
                transpose_item(AIN(I_WBR) + ((size_t)(LL) * 4 + n) * MIXW * D, D, (WBRp) + (size_t)n * D * MIXW, MIXW, kb * 64, n0, n0, scr, lane); break; } r -= 3 * I_BR; \
            if (r < I_OUT) { const int nb = D / 32, kb = r / nb, n0 = (r % nb) * 32; transpose_item(AIN(I_WOUT) + (size_t)(LL) * D * D, D, (WOUTp), D, kb * 64, n0, n0, scr, lane); break; } r -= I_OUT; \
            if (r < 2 * I_GU) { const int up = r / I_GU, rr = r % I_GU, nb = DFF / 32, kb = rr / nb, n0 = (rr % nb) * 32; \
                transpose_item(AIN(up ? I_WU : I_WG) + (size_t)(LL) * D * DFF, DFF, (WGUp), D, kb * 64, n0, (n0 / 128) * 256 + (n0 % 128) + up * 128, scr, lane); break; } r -= 2 * I_GU; \
            { const int nb = D / 32, kb = r / nb, n0 = (r % nb) * 32; transpose_item(AIN(I_WD) + (size_t)(LL) * DFF * D, D, (WDp), DFF, kb * 64, n0, n0, scr, lane); } } while (0)
    constexpr int XPRE = 8192;
    static_assert(XPRE % (64 * 8) == 0 && XPRE < NIT, "pre-conversion share");
    constexpr int KS = 8, KSL = D / KS, NCB = 6 * D / 256;
    float* PART = (float*)(ws + WS_GATES);
    if (IN(0)) { long gt = gt0; asm volatile("" : "+v"(gt));
        for (long i = gt; i < 64 * 16; i += NGT) { const int pos = (int)(i / 16), f = (int)(i % 16); const float inv = powf(10000.0f, -(float)f / 16.0f); const float a = (float)pos * inv; F2 cs; cs.x = cosf(a); cs.y = sinf(a); RT[i] = cs; }
        for (long i = gt; i < NL * 64; i += NGT) { const int l_ = (int)(i / 64), e_ = (int)(i % 64); KG[l_ * 192 + e_] = AIN(I_AKN)[i]; KG[l_ * 192 + 64 + e_] = AIN(I_BKN)[i]; KG[l_ * 192 + 128 + e_] = AIN(I_CKN)[i]; }
        if (gt < NL) { const int l = (int)gt; float s1 = 0.f, s2 = 0.f;
            for (int i = 0; i < HDIM; ++i) { s1 += AIN(I_LQ1)[l * HDIM + i] * AIN(I_LK1)[l * HDIM + i]; s2 += AIN(I_LQ2)[l * HDIM + i] * AIN(I_LK2)[l * HDIM + i]; }
            const float li = 0.8f - 0.6f * expf(-0.3f * (float)l); LAM[2 * l] = expf(s1) - expf(s2) + li; LAM[2 * l + 1] = li; }
        int lane = lane0; asm volatile("" : "+v"(lane));
        static_assert(NCB % NWAVES == 0, "the 8 wave tasks of a workgroup share (layer, K slice)");
        LAS float* st = (LAS float*)lds;
        for (int t0 = bx * NWAVES; t0 < NL * KS * NCB; t0 += NGW) {
            const int cb = (t0 + wave) % NCB, ks = (t0 / NCB) % KS, l = t0 / (NCB * KS);
            __syncthreads();
            for (int i = tid; i < (NB + 1) * KSL; i += NTHR) { const int r = i / KSL, k = i - r * KSL; const float cv = r < NB ? AIN(I_C)[r * D + ks * KSL + k] : AIN(I_CCTX)[ks * KSL + k]; st[i] = cv / (1.0f + __expf(-cv)); }
            __syncthreads();
            const float* w = AIN(I_WADA) + ((size_t)l * D + (size_t)ks * KSL) * 6 * D + cb * 256 + 4 * lane;
            f32x4 a[NB + 1];
#pragma unroll
            for (int r = 0; r <= NB; ++r) a[r] = (f32x4){0.f, 0.f, 0.f, 0.f};
            f32x4 w0[4], w1[4];
#pragma unroll
            for (int i = 0; i < 4; ++i) w0[i] = *(const f32x4*)(w + (size_t)i * 6 * D);
#define ADA_ROWS(wv, kk) do { f32x4 ca = *(const LAS f32x4*)(st + (kk)); \
                _Pragma("unroll") for (int r = 0; r <= NB; ++r) { f32x4 na = ca; if (r < NB) na = *(const LAS f32x4*)(st + (r + 1) * KSL + (kk)); \
                    a[r] += wv[0] * ca.x; a[r] += wv[1] * ca.y; a[r] += wv[2] * ca.z; a[r] += wv[3] * ca.w; \
                    __builtin_amdgcn_sched_barrier(0); ca = na; } } while (0)
#pragma unroll 1
            for (int k = 0; k < KSL; k += 8) {
#pragma unroll
                for (int i = 0; i < 4; ++i) w1[i] = *(const f32x4*)(w + (size_t)(k + 4 + i) * 6 * D);
                ADA_ROWS(w0, k);
                if (k + 8 < KSL) {
#pragma unroll
                    for (int i = 0; i < 4; ++i) w0[i] = *(const f32x4*)(w + (size_t)(k + 8 + i) * 6 * D); }
                ADA_ROWS(w1, k + 4);
            }
#undef ADA_ROWS
#pragma unroll
            for (int r = 0; r <= NB; ++r) *(f32x4*)(PART + (((size_t)l * KS + ks) * (NB + 1) + r) * 6 * D + cb * 256 + 4 * lane) = a[r];
        }
    }
    if (IN(0) && bx >= 192) {
        int lane = lane0; asm volatile("" : "+v"(lane));
        LAS float* scr = (LAS float*)(lds + wave * 16384);
        for (int it = (bx - 192) * NWAVES + wave; it < XPRE; it += 64 * NWAVES)
            CONV_ITEM(it, 0, (bf16*)(ws + WS_WBR), (bf16*)(ws + WS_WOUT), (bf16*)(ws + WS_WGU), (bf16*)(ws + WS_WD));
    }
    SEAM(0);
    if (IN(1)) { long gt = gt0; asm volatile("" : "+v"(gt));
        for (long i = gt; i < (long)NL * (NB + 1) * (6 * D / 4); i += NGT) { const int j4 = (int)(i % (6 * D / 4)), r = (int)((i / (6 * D / 4)) % (NB + 1)), l = (int)(i / ((long)(6 * D / 4) * (NB + 1)));
            f32x4 s = *(const f32x4*)(AIN(I_BADA) + (size_t)l * 6 * D + 4 * j4);
#pragma unroll
            for (int ks = 0; ks < KS; ++ks) s += *(const f32x4*)(PART + (((size_t)l * KS + ks) * (NB + 1) + r) * 6 * D + 4 * j4);
            *(f32x4*)(MODV + ((size_t)l * (NB + 1) + r) * 6 * D + 4 * j4) = s; }
    }
    SEAM(1);
    for (int l = 0; l < NL; ++l) {
        const int pb = NPRO + l * NPL; const bool lastl = (l == NL - 1);
        const float* modl = MODV + (size_t)l * (NB + 1) * 6 * D;
#define XSRC() (l == 0 ? AIN(I_X) : (const float*)args.out)
#define CSRC() (l == 0 ? AIN(I_CTX) : (const float*)CTXR)

#define WOFS_ ((l & 1) ? (WS_W2 - WS_WBR) : (size_t)0)
#define WOFN_ ((l & 1) ? (size_t)0 : (WS_W2 - WS_WBR))
#define WBR_T ((bf16*)(ws + WS_WBR + WOFS_))
#define WOUT_T ((bf16*)(ws + WS_WOUT + WOFS_))
#define WGU_T ((bf16*)(ws + WS_WGU + WOFS_))
#define WD_T ((bf16*)(ws + WS_WD + WOFS_))
#define WBR_N ((bf16*)(ws + WS_WBR + WOFN_))
#define WOUT_N ((bf16*)(ws + WS_WOUT + WOFN_))
#define WGU_N ((bf16*)(ws + WS_WGU + WOFN_))
#define WD_N ((bf16*)(ws + WS_WD + WOFN_))
#define POOL_FOLD(LL, WBRp) do { \
            for (int task = gw; task < (MIXW / 8) * (D / 64); task += NGW) { \
                const int kc8 = task % (MIXW / 8), db = task / (MIXW / 8), k0 = kc8 * 8, g = k0 / PGW, c0 = k0 % PGW, d = db * 64 + lane; \
                const float* dw = AIN(I_DW) + (size_t)(LL) * 4 * PGW * PGW + ((size_t)g * PGW + c0) * PGW; \
                const float* dsc = AIN(I_DSCALE) + (LL) * MIXW + g * PGW; \
                const float* wb = AIN(I_WBR) + ((size_t)(LL) * 4 + 3) * MIXW * D + (size_t)(g * PGW) * D + d; \
                float a[8]; \
                _Pragma("unroll") for (int i = 0; i < 8; ++i) a[i] = 0.f; \
                _Pragma("unroll 1") for (int e0 = 0; e0 < PGW; e0 += 16) { float wv[16];                         \
                    _Pragma("unroll") for (int e = 0; e < 16; ++e) wv[e] = wb[(size_t)(e0 + e) * D]; \
                    _Pragma("unroll") for (int e = 0; e < 16; ++e) { const float ws_ = wv[e] * dsc[e0 + e]; \
                        _Pragma("unroll") for (int i = 0; i < 8; ++i) a[i] += dw[i * PGW + e0 + e] * ws_; } } \
                v4u o; o.x = pk2(a[0], a[1]); o.y = pk2(a[2], a[3]); o.z = pk2(a[4], a[5]); o.w = pk2(a[6], a[7]); \
                *(v4u*)((WBRp) + (size_t)3 * D * MIXW + (size_t)d * MIXW + k0) = o; } } while (0)

        if (IN(pb + 0) && l == 0) {
            int lane = lane0; asm volatile("" : "+v"(lane));
            LAS float* scr = (LAS float*)(lds + wave * 16384);
            for (int it = XPRE + gw; it < NIT; it += NGW) CONV_ITEM(it, 0, WBR_T, WOUT_T, WGU_T, WD_T);
            POOL_FOLD(0, WBR_T);
        }
#define NORM_PHASE_F(nrows, gainp, CH_SH, CH_SC, srcl, srcc) do { int lane = lane0; asm volatile("" : "+v"(lane)); \
            for (int m = gw; m < (nrows); m += NGW) { const bool isc = m >= M_LAT; \
                const float* xr = isc ? (srcc) + (size_t)(m - M_LAT) * D : (srcl) + (size_t)m * D; \
                const float* mr = modl + (size_t)(isc ? NB : m / S) * 6 * D; \
                f32x4 v[D / 256]; float ss = 0.f; \
                _Pragma("unroll") for (int j = 0; j < D / 256; ++j) { v[j] = *(const f32x4*)(xr + 4 * lane + 256 * j); ss += (v[j].x * v[j].x + v[j].y * v[j].y) + (v[j].z * v[j].z + v[j].w * v[j].w); } \
                const float rs = 1.0f / sqrtf(wave_sum(ss) * (1.0f / D) + NORM_EPS); \
                _Pragma("unroll") for (int j = 0; j < D / 256; ++j) { const int c = 4 * lane + 256 * j; \
                    const f32x4 gn = *(const f32x4*)((gainp) + c), sh = *(const f32x4*)(mr + (CH_SH) * D + c), sc = *(const f32x4*)(mr + (CH_SC) * D + c); \
                    const f32x4 y = (v[j] * rs * gn) * (sc + 1.0f) + sh; \
                    unsigned long long o = (unsigned long long)pk2(y.x, y.y) | ((unsigned long long)pk2(y.z, y.w) << 32); \
                    *(unsigned long long*)(H + (size_t)m * D + c) = o; \
                    unsigned long long xo = (unsigned long long)pk2(v[j].x, v[j].y) | ((unsigned long long)pk2(v[j].z, v[j].w) << 32); \
                    *(unsigned long long*)(XB + (size_t)m * D + c) = xo; } } } while (0)
#define NORM_UNP(u, x0, x1) do { x0.x = bflo(u.x); x0.y = bfhi(u.x); x0.z = bflo(u.y); x0.w = bfhi(u.y); x1.x = bflo(u.z); x1.y = bfhi(u.z); x1.z = bflo(u.w); x1.w = bfhi(u.w); } while (0)
#define NORM_PHASE_B(nrows, gainp, CH_SH, CH_SC) do { int lane = lane0; asm volatile("" : "+v"(lane)); \
            for (int p = gw; p < (nrows) / 2; p += NGW) { const int m = 2 * p; const bool isc = m >= M_LAT;        \
                const bf16* xr = XB + (size_t)m * D; \
                const float* mr = modl + (size_t)(isc ? NB : m / S) * 6 * D; \
                u32x4 v[2][D / 512]; float ss0 = 0.f, ss1 = 0.f; \
                _Pragma("unroll") for (int j = 0; j < D / 512; ++j) { v[0][j] = *(const u32x4*)(xr + 8 * lane + 512 * j); v[1][j] = *(const u32x4*)(xr + D + 8 * lane + 512 * j); } \
                if (isc) { const float* pr = PB + (size_t)(m - M_LAT) * D + 8 * lane;        \
                    _Pragma("unroll") for (int j = 0; j < D / 512; ++j) _Pragma("unroll") for (int r_ = 0; r_ < 2; ++r_) { \
                        const f32x4 p0 = *(const f32x4*)(pr + (size_t)r_ * D + 512 * j), p1 = *(const f32x4*)(pr + (size_t)r_ * D + 512 * j + 4); \
                        f32x4 x0, x1; NORM_UNP(v[r_][j], x0, x1); x0 += p0; x1 += p1; \
                        u32x4 o; o.x = pk2(x0.x, x0.y); o.y = pk2(x0.z, x0.w); o.z = pk2(x1.x, x1.y); o.w = pk2(x1.z, x1.w); v[r_][j] = o; \
                        *(u32x4*)(XB + (size_t)(m + r_) * D + 8 * lane + 512 * j) = o; } } \
                _Pragma("unroll") for (int j = 0; j < D / 512; ++j) { f32x4 x0, x1; NORM_UNP(v[0][j], x0, x1); \
                    ss0 += ((x0.x * x0.x + x0.y * x0.y) + (x0.z * x0.z + x0.w * x0.w)) + ((x1.x * x1.x + x1.y * x1.y) + (x1.z * x1.z + x1.w * x1.w)); \
                    NORM_UNP(v[1][j], x0, x1); \
                    ss1 += ((x0.x * x0.x + x0.y * x0.y) + (x0.z * x0.z + x0.w * x0.w)) + ((x1.x * x1.x + x1.y * x1.y) + (x1.z * x1.z + x1.w * x1.w)); } \
                const float rs0 = 1.0f / sqrtf(wave_sum(ss0) * (1.0f / D) + NORM_EPS), rs1 = 1.0f / sqrtf(wave_sum(ss1) * (1.0f / D) + NORM_EPS); \
                _Pragma("unroll") for (int j = 0; j < D / 512; ++j) { const int c = 8 * lane + 512 * j; \
                    const f32x4 gn0 = *(const f32x4*)((gainp) + c), sh0 = *(const f32x4*)(mr + (CH_SH) * D + c), sc0 = *(const f32x4*)(mr + (CH_SC) * D + c); \
                    const f32x4 gn1 = *(const f32x4*)((gainp) + c + 4), sh1 = *(const f32x4*)(mr + (CH_SH) * D + c + 4), sc1 = *(const f32x4*)(mr + (CH_SC) * D + c + 4); \
                    const f32x4 m0 = gn0 * (sc0 + 1.0f), m1 = gn1 * (sc1 + 1.0f); \
                    f32x4 x0, x1; NORM_UNP(v[0][j], x0, x1); \
                    f32x4 y0 = (x0 * rs0) * m0 + sh0, y1 = (x1 * rs0) * m1 + sh1; \
                    u32x4 o; o.x = pk2(y0.x, y0.y); o.y = pk2(y0.z, y0.w); o.z = pk2(y1.x, y1.y); o.w = pk2(y1.z, y1.w); \
                    *(u32x4*)(H + (size_t)m * D + c) = o; \
                    NORM_UNP(v[1][j], x0, x1); \
                    y0 = (x0 * rs1) * m0 + sh0; y1 = (x1 * rs1) * m1 + sh1; \
                    o.x = pk2(y0.x, y0.y); o.y = pk2(y0.z, y0.w); o.z = pk2(y1.x, y1.y); o.w = pk2(y1.z, y1.w); \
                    *(u32x4*)(H + (size_t)(m + 1) * D + c) = o; } } } while (0)
        if (IN(pb + 0)) { if (l == 0) { const float* xs_ = AIN(I_X); const float* cs_ = AIN(I_CTX); NORM_PHASE_F(MT, AIN(I_NMIX) + (size_t)l * D, 0, 1, xs_, cs_); }
                          else NORM_PHASE_B(MT, AIN(I_NMIX) + (size_t)l * D, 0, 1); }
        SEAM(pb + 0);

        if (IN(pb + 1)) {
            pg8::Gemm g{H, WIN_T, D, D, D};
            pg8::Sched Sd{M_LAT / 256, PROJW / 256, M_CTX / 256, lastl ? NQKV / 256 : PROJW / 256, 1, G, bx, 0, 0, 0, 0};
            EpiWin E{QKV, GATES, KG + l * 192, RT};
            pg8::gemm_phase<EpiWin>(lds, g, Sd, E);
        }
        SEAM(pb + 1);

#define MAKE_P() LayerP P; P.aqn = AIN(I_AQN) + l * HDIM; P.akn = AIN(I_AKN) + l * HDIM; P.rpb = AIN(I_RPB) + (size_t)l * NAH * (2 * NAR - 1) * (2 * NAC - 1); \
        P.bqn = AIN(I_BQN) + l * HDIM; P.bkn = AIN(I_BKN) + l * HDIM; P.subln = AIN(I_SUBLN) + l * 128; P.cqn = AIN(I_CQN) + l * HDIM; P.ckn = AIN(I_CKN) + l * HDIM; \
        P.sink = AIN(I_SINK) + l * SWH; P.dw = AIN(I_DW) + (size_t)l * 4 * PGW * PGW; P.dscale = AIN(I_DSCALE) + l * MIXW

        if (IN(pb + 3)) {
            MAKE_P();
            int tidl = tid; asm volatile("" : "+v"(tidl));
#define lanel (tidl & 63)
            const float lam = LAM[2 * l], lami = LAM[2 * l + 1];
            constexpr int U_DIFF = NB * DFH * (S / 128), U_NA = NB * NAH * (ROWS / 4), U_SWA = NB * SKV * (S / 64);
            constexpr int U_DIFFC = NB * DFH * (CL / 128), U_NAC = NB * NAH * (CL / 256), U_SWAC = NB * SKV * (CL / 64);
            static_assert(U_DIFF % 8 == 0 && U_NA % 8 == 0 && U_SWA % 8 == 0 && U_DIFFC % 8 == 0 && U_NAC % 8 == 0 && U_SWAC % 8 == 0, "unit counts");
            const int utot = U_DIFF + U_NA + U_SWA + (lastl ? 0 : U_DIFFC + U_NAC + U_SWAC);
            #define XREM(v, n) (((v) % 8) * ((n) / 8) + (v) / 8)
            for (int u = bx; u < U_DIFF; u += G) { int v = u; if (v < U_DIFF) { v = XREM(v, U_DIFF); const int qb = v % (S / 128), h = (v / (S / 128)) % DFH, b = v / ((S / 128) * DFH); attn_diff_unit<false>(lds, QKV, VT, O, b, h, qb, lam, lami, P.subln, P.bqn, RT, tidl, wave, lanel); continue; } v -= U_DIFF; }
            if (!lastl) for (int u = bx; u < U_DIFFC; u += G) { int v = u; if (v < U_DIFFC) { v = XREM(v, U_DIFFC); const int qb = v % (CL / 128), h = (v / (CL / 128)) % DFH, b = v / ((CL / 128) * DFH); attn_diff_unit<true>(lds, QKV, VT, O, b, h, qb, lam, lami, P.subln, P.bqn, RT, tidl, wave, lanel); continue; } v -= U_DIFFC; }
#define CONV_STEPS(uc_) ((uc_) < 8 ? 2 * (uc_) : (uc_) + 8)
            const int utot2 = U_NA + U_SWA + (lastl ? 0 : U_NAC + U_SWAC);
            for (int u = bx; u < utot2; u += G) {
                if (!lastl) {
                    const int uc = (u - bx) / G; int cit = gw + CONV_STEPS(uc) * NGW; const int cend = gw + CONV_STEPS(uc + 1) * NGW;
                    if (cit < NIT) {
                        int lane = lanel; LAS float* scr = (LAS float*)(lds + wave * 16384);
                        __syncthreads();
                        for (; cit < cend && cit < NIT; cit += NGW) CONV_ITEM(cit, l + 1, WBR_N, WOUT_N, WGU_N, WD_N);
                    }
                }
                int v = u;
                if (v < U_NA) { v = XREM(v, U_NA); const int rg = v % (ROWS / 4), hd = (v / (ROWS / 4)) % NAH, b = v / ((ROWS / 4) * NAH); attn_na_unit<false>(lds, QKV, VT, O, b, hd, rg, P.rpb, P.aqn, RT, tidl, wave, lanel); continue; } v -= U_NA;
                if (v < U_SWA) { v = XREM(v, U_SWA); const int qb = v % (S / 64), kvh = (v / (S / 64)) % SKV, b = v / ((S / 64) * SKV); attn_swa_unit<false>(lds, QKV, VT, O, b, kvh, qb, P.sink, P.cqn, RT, tidl, wave, lanel); continue; } v -= U_SWA;
                if (v < U_NAC) { v = XREM(v, U_NAC); const int rg = v % (CL / 256), hd = (v / (CL / 256)) % NAH, b = v / ((CL / 256) * NAH); attn_na_unit<true>(lds, QKV, VT, O, b, hd, rg, P.rpb, P.aqn, RT, tidl, wave, lanel); continue; } v -= U_NAC;
                { v = XREM(v, U_SWAC); const int qb = v % (CL / 64), kvh = (v / (CL / 64)) % SKV, b = v / ((CL / 64) * SKV); attn_swa_unit<true>(lds, QKV, VT, O, b, kvh, qb, P.sink, P.cqn, RT, tidl, wave, lanel); }
            }
            if (!lastl) {
                int lane = lanel; LAS float* scr = (LAS float*)(lds + wave * 16384);
                __syncthreads();
                static_assert(CONV_STEPS((U_NA + U_SWA + U_NAC + U_SWAC) / 256) * 2048 >= NIT, "every workgroup's in-loop conversion steps cover all items (256 workgroups x 8 waves)");
                POOL_FOLD(l + 1, WBR_N);
            }
            {
                const int pm_rows = lastl ? M_LAT : MT; long gt = gt0; asm volatile("" : "+v"(gt));
                for (long i = gt; i < (long)pm_rows * 16; i += NGT) { const int m = (int)(i >> 4), cl = (int)(i & 15);
                    pool_d_w<2>(QKV, O + 3 * MIXW, D, m, cl); pool_d_w<4>(QKV, O + 3 * MIXW, D, m, 16 + cl); pool_d_w<8>(QKV, O + 3 * MIXW, D, m, 32 + cl); pool_d_w<16>(QKV, O + 3 * MIXW, D, m, 48 + cl); } }
        }
#undef lanel
        SEAM(pb + 3);

        if (IN(pb + 4)) {
            pg8::merge_phase(lds, O, WBR_T, GATES, ACC, lastl ? M_LAT / 256 : MT / 256, G, bx);
        }
        SEAM(pb + 4);

        if (IN(pb + 5)) {
            pg8::Gemm g{ACC, WOUT_T, D, D, D};
            pg8::Sched Sd{M_LAT / 256, D / 256, lastl ? 0 : M_CTX / 256, D / 256, 1, G, bx, (size_t)(D / 2), D / 2, 0, 1};
            EpiResid E{XB, nullptr, PB, modl, 2};
            pg8::gemm_phase<EpiResid>(lds, g, Sd, E);
        }
        SEAM(pb + 5);

        if (IN(pb + 6)) { const int nr = lastl ? M_LAT : MT; NORM_PHASE_B(nr, AIN(I_NFFN) + (size_t)l * D, 3, 4); }
        SEAM(pb + 6);

        if (IN(pb + 7)) {
            pg8::Gemm g{H, WGU_T, D, D, D};
            pg8::Sched Sd{M_LAT / 256, 2 * DFF / 256, lastl ? 0 : M_CTX / 256, 2 * DFF / 256, 1, G, bx, 0, 0, 0, 0};
            EpiFfnUp E{HID};
            pg8::gemm_phase<EpiFfnUp>(lds, g, Sd, E);
        }
        SEAM(pb + 7);

        if (IN(pb + 8)) {
            pg8::Gemm g{HID, WD_T, DFF, DFF, DFF};
            pg8::Sched Sd{M_LAT / 256, D / 256, lastl ? 0 : M_CTX / 256, D / 256, 1, G, bx, (size_t)(DFF / 2), DFF / 2, 1, 1};
            EpiResid E{XB, lastl ? args.out : nullptr, PB, modl, 5};
            pg8::gemm_phase<EpiResid>(lds, g, Sd, E);
        }
        SEAM(pb + 8);
    }
#undef IN
#undef SEAM
#undef AIN
#undef XSRC
#undef CSRC
#undef NORM_PHASE_F
#undef CONV_ITEM
#undef WOFS_
#undef WOFN_
#undef WBR_T
#undef WOUT_T
#undef WGU_T
#undef WD_T
#undef WBR_N
#undef WOUT_N
#undef WGU_N
#undef WD_N
#undef CONV_STEPS
#undef POOL_FOLD
#undef NORM_PHASE_B
#undef NORM_UNP
#undef MAKE_P
}

#ifndef MK_PER_PHASE
#define MK_PER_PHASE 0
#endif
extern "C" void kernel_launch(void* const* d_in, const int* in_sizes, int n_in, void* d_out, int out_size, void* d_ws, size_t ws_size, hipStream_t stream) {
    static int grid = 0;
    if (grid == 0) {
        if (n_in != 29 || out_size != M_LAT * D || ws_size < WS_END) { fprintf(stderr, "kernel_launch: unexpected shapes (n_in %d out %d ws %zu need %zu)\n", n_in, out_size, ws_size, (size_t)WS_END); grid = -1; return; }
        int dev = 0, cus = 0, per_cu = 0;
        if (hipGetDevice(&dev) != hipSuccess || hipDeviceGetAttribute(&cus, hipDeviceAttributeMultiprocessorCount, dev) != hipSuccess) { grid = -1; return; }
        if (hipFuncSetAttribute((const void*)mega, hipFuncAttributeMaxDynamicSharedMemorySize, LDS_BYTES) != hipSuccess) { fprintf(stderr, "kernel_launch: hipFuncSetAttribute failed\n"); grid = -1; return; }
        if (hipOccupancyMaxActiveBlocksPerMultiprocessor(&per_cu, (const void*)mega, NTHR, LDS_BYTES) != hipSuccess || per_cu < 1) fprintf(stderr, "kernel_launch: occupancy query reports %d\n", per_cu);
        (void)hipGetLastError();
        grid = cus > 256 ? 256 : cus;
    }
    if (grid < 0) return;
    if (hipMemsetAsync((char*)d_ws + WS_CTL, 0, CTL_ZERO_BYTES, stream) != hipSuccess) return;
    Args a{};
    for (int i = 0; i < 29; ++i) a.in[i] = (const float*)d_in[i];
    a.out = (float*)d_out; a.ws = (unsigned char*)d_ws;
#if MK_PER_PHASE
    for (int p = 0; p < NPHASE; ++p) { a.ph_lo = p; a.ph_hi = p + 1;
        hipLaunchKernelGGL(mega, dim3(grid), dim3(NTHR), LDS_BYTES, stream, a); }
#else
    a.ph_lo = 0; a.ph_hi = NPHASE; hipLaunchKernelGGL(mega, dim3(grid), dim3(NTHR), LDS_BYTES, stream, a);
#endif
}
#endif
```

```cpp
#ifndef HOST_EMU
#include <hip/hip_runtime.h>
#endif
#include <cstdio>
#include <cstdint>
#include <cmath>
#include <cstring>

#ifndef CFG_D
#define CFG_D 2048
#endif
#ifndef CFG_B
#define CFG_B 16
#endif
#ifndef CFG_S
#define CFG_S 2048
#endif
#ifndef CFG_L
#define CFG_L 4
#endif
#ifndef CFG_CL
#define CFG_CL 256
#endif
constexpr int D = CFG_D, NB = CFG_B, S = CFG_S, NL = CFG_L, CL = CFG_CL;
constexpr int GW = 64, HDIM = 64, MIXW = D / 4, NAH = MIXW / 64, DFH = MIXW / 128, SWH = MIXW / 64, SKV = 2, SG = SWH / SKV;
constexpr int PGW = MIXW / 4, DFF = ((8 * D + 767) / 768) * 256, ROWS = S / GW, NAR = 8, NAC = 16, SWW = 128;
constexpr int C_AQ = 0, C_AK = MIXW, C_AV = 2 * MIXW, C_BQ = 3 * MIXW, C_BK = 4 * MIXW, C_BV = 5 * MIXW, C_SQ = 6 * MIXW, C_SK = 7 * MIXW, C_SV = 7 * MIXW + SKV * HDIM, C_DU = 7 * MIXW + 2 * SKV * HDIM;
constexpr int NQKV = C_DU + MIXW, NGATE = 4 * D, PROJW = NQKV + NGATE;
constexpr int M_LAT = NB * S, M_CTX = NB * CL, MT = M_LAT + M_CTX;
constexpr int NSLOT = 2 * NAH + 4 * DFH + SWH + SKV;
constexpr float NORM_EPS = 1e-6f;
static_assert(ROWS >= NAR && ROWS <= 64, "grid rows");

#ifdef HOST_EMU
#define HDF inline
#define FEXP(x) expf(x)
#else
#define HDF __device__ __forceinline__
#define FEXP(x) __expf(x)
#endif

typedef unsigned short bf16;
struct alignas(16) U4 { unsigned x, y, z, w; };
struct alignas(8) F2 { float x, y; };

HDF float bf2f(bf16 h) { unsigned u = (unsigned)h << 16; float f; memcpy(&f, &u, 4); return f; }
HDF float bflo(unsigned u) { unsigned v = u << 16; float f; memcpy(&f, &v, 4); return f; }
HDF float bfhi(unsigned u) { unsigned v = u & 0xffff0000u; float f; memcpy(&f, &v, 4); return f; }
HDF unsigned f2bf(float f) { unsigned u; memcpy(&u, &f, 4); return (u + 0x7fffu + ((u >> 16) & 1u)) >> 16; }
HDF unsigned pk2(float lo, float hi) { return f2bf(lo) | (f2bf(hi) << 16); }

struct LayerP { const float *aqn, *akn, *rpb, *bqn, *bkn, *subln, *cqn, *ckn, *sink, *dw, *dscale; };

HDF void row_decode(int m, bool& isctx, int& b, int& t) {
    isctx = m >= M_LAT;
    if (!isctx) { b = m / S; t = m - b * S; } else { const int r = m - M_LAT; b = r / CL; t = r - b * CL; }
}

HDF void load64(const bf16* p, float (&x)[64]) {
#pragma unroll
    for (int i = 0; i < 8; ++i) { const U4 v = *(const U4*)(p + 8 * i);
        x[8 * i + 0] = bflo(v.x); x[8 * i + 1] = bfhi(v.x); x[8 * i + 2] = bflo(v.y); x[8 * i + 3] = bfhi(v.y);
        x[8 * i + 4] = bflo(v.z); x[8 * i + 5] = bfhi(v.z); x[8 * i + 6] = bflo(v.w); x[8 * i + 7] = bfhi(v.w); }
}
HDF float dot64(const float (&q)[64], const bf16* p) {
    float s0 = 0.f, s1 = 0.f;
#pragma unroll
    for (int i = 0; i < 8; ++i) { const U4 v = *(const U4*)(p + 8 * i);
        s0 += q[8 * i + 0] * bflo(v.x); s1 += q[8 * i + 1] * bfhi(v.x); s0 += q[8 * i + 2] * bflo(v.y); s1 += q[8 * i + 3] * bfhi(v.y);
        s0 += q[8 * i + 4] * bflo(v.z); s1 += q[8 * i + 5] * bfhi(v.z); s0 += q[8 * i + 6] * bflo(v.w); s1 += q[8 * i + 7] * bfhi(v.w); }
    return s0 + s1;
}
HDF void osm_step(float s, const bf16* vrow, float& mx, float& l, float (&acc)[64]) {
    if (s > mx) { const float c = FEXP(mx - s); l *= c;
#pragma unroll
        for (int d = 0; d < 64; ++d) acc[d] *= c;
        mx = s; }
    const float p = FEXP(s - mx); l += p;
#pragma unroll
    for (int i = 0; i < 8; ++i) { const U4 v = *(const U4*)(vrow + 8 * i);
        acc[8 * i + 0] += p * bflo(v.x); acc[8 * i + 1] += p * bfhi(v.x); acc[8 * i + 2] += p * bflo(v.y); acc[8 * i + 3] += p * bfhi(v.y);
        acc[8 * i + 4] += p * bflo(v.z); acc[8 * i + 5] += p * bfhi(v.z); acc[8 * i + 6] += p * bflo(v.w); acc[8 * i + 7] += p * bfhi(v.w); }
}
HDF void store64(bf16* p, const float (&a)[64], float sc) {
#pragma unroll
    for (int i = 0; i < 8; ++i) { U4 v; v.x = pk2(a[8 * i] * sc, a[8 * i + 1] * sc); v.y = pk2(a[8 * i + 2] * sc, a[8 * i + 3] * sc);
        v.z = pk2(a[8 * i + 4] * sc, a[8 * i + 5] * sc); v.w = pk2(a[8 * i + 6] * sc, a[8 * i + 7] * sc); *(U4*)(p + 8 * i) = v; }
}

HDF void prep_body(bf16* QKV, int m, int slot, const LayerP& P, const F2* RT) {
    int s = slot, col0; const float* g; bool isq, rope;
    if (s < NAH) { col0 = C_AQ + 64 * s; g = P.aqn; isq = true; rope = false; }
    else if ((s -= NAH) < NAH) { col0 = C_AK + 64 * s; g = P.akn; isq = false; rope = false; }
    else if ((s -= NAH) < 2 * DFH) { col0 = C_BQ + 64 * s; g = P.bqn; isq = true; rope = true; }
    else if ((s -= 2 * DFH) < 2 * DFH) { col0 = C_BK + 64 * s; g = P.bkn; isq = false; rope = true; }
    else if ((s -= 2 * DFH) < SWH) { col0 = C_SQ + 64 * s; g = P.cqn; isq = true; rope = true; }
    else { s -= SWH; col0 = C_SK + 64 * s; g = P.ckn; isq = false; rope = true; }
    bool isctx; int b, t; row_decode(m, isctx, b, t);
    bf16* p = QKV + (size_t)m * NQKV + col0;
    float x[64]; load64(p, x);
    float ss = 0.f;
#pragma unroll
    for (int i = 0; i < 64; ++i) ss += x[i] * x[i];
    const float r = 1.0f / sqrtf(ss * (1.f / 64.f) + NORM_EPS);
#pragma unroll
    for (int i = 0; i < 64; ++i) x[i] = x[i] * r * g[i];
    if (rope && !isctx) {
#pragma unroll
        for (int pp = 0; pp < 2; ++pp) { const int pos = pp == 0 ? t / GW : t % GW;
#pragma unroll
            for (int f = 0; f < 16; ++f) { const F2 cs = RT[pos * 16 + f]; const float a = x[pp * 32 + f], b2 = x[pp * 32 + 16 + f];
                x[pp * 32 + f] = a * cs.x - b2 * cs.y; x[pp * 32 + 16 + f] = b2 * cs.x + a * cs.y; } }
    }
    store64(p, x, isq ? 0.125f : 1.0f);
}

HDF void pool_d_body(const bf16* QKV, bf16* OUT, int ldo, int m, int c8) {
    bool isctx; int b, t; row_decode(m, isctx, b, t);
    const int T = isctx ? CL : S, ch = c8 * 8, g = ch / PGW, w = 2 << g;
    int lo = t - w / 2; if (lo < 0) lo = 0; int hi = t - w / 2 + w; if (hi > T) hi = T;
    const bf16* base = QKV + (size_t)(m - t) * NQKV + C_DU + ch;
    float sum[8];
#pragma unroll
    for (int i = 0; i < 8; ++i) sum[i] = 0.f;
    for (int j = lo; j < hi; ++j) { const U4 v = *(const U4*)(base + (size_t)j * NQKV);
        sum[0] += bflo(v.x); sum[1] += bfhi(v.x); sum[2] += bflo(v.y); sum[3] += bfhi(v.y); sum[4] += bflo(v.z); sum[5] += bfhi(v.z); sum[6] += bflo(v.w); sum[7] += bfhi(v.w); }
    const float inv = 1.0f / (float)(hi - lo);
    const U4 u = *(const U4*)(base + (size_t)t * NQKV);
    U4 o; o.x = pk2(sum[0] * inv - bflo(u.x), sum[1] * inv - bfhi(u.x)); o.y = pk2(sum[2] * inv - bflo(u.y), sum[3] * inv - bfhi(u.y));
    o.z = pk2(sum[4] * inv - bflo(u.z), sum[5] * inv - bfhi(u.z)); o.w = pk2(sum[6] * inv - bflo(u.w), sum[7] * inv - bfhi(u.w));
    *(U4*)(OUT + (size_t)m * ldo + ch) = o;
}
HDF void pool_mm_body(const bf16* DPOOL, bf16* O, int m, int e, const LayerP& P) {
    const int g = e / PGW, eo = e - g * PGW; const bf16* dp = DPOOL + (size_t)m * MIXW + g * PGW; const float* w = P.dw + (size_t)g * PGW * PGW + eo;
    float acc = 0.f;
    for (int c = 0; c < PGW; ++c) acc += bf2f(dp[c]) * w[(size_t)c * PGW];
    O[(size_t)m * D + 3 * MIXW + e] = (bf16)f2bf(acc * P.dscale[e]);
}

HDF void na_body(const bf16* QKV, bf16* O, int m, int h, const LayerP& P) {
    bool isctx; int b, t; row_decode(m, isctx, b, t);
    float q[64], acc[64]; load64(QKV + (size_t)m * NQKV + C_AQ + 64 * h, q);
#pragma unroll
    for (int d = 0; d < 64; ++d) acc[d] = 0.f;
    float mx = -INFINITY, l = 0.f;
    if (!isctx) {
        const int r = t / GW, qc = t % GW;
        int rs = r - NAR / 2; if (rs < 0) rs = 0; if (rs > ROWS - NAR) rs = ROWS - NAR;
        int cs = qc - NAC / 2; if (cs < 0) cs = 0; if (cs > GW - NAC) cs = GW - NAC;
        for (int kk = 0; kk < NAR; ++kk) { const int krow = rs + kk, dr = krow - r + (NAR - 1);
            for (int kx = 0; kx < NAC; ++kx) { const int kc = cs + kx; const bf16* kp = QKV + (size_t)(b * S + krow * GW + kc) * NQKV;
                const float s = dot64(q, kp + C_AK + 64 * h) + P.rpb[(h * (2 * NAR - 1) + dr) * (2 * NAC - 1) + (kc - qc + NAC - 1)];
                osm_step(s, kp + C_AV + 64 * h, mx, l, acc); } }
    }
    for (int c = 0; c < CL; ++c) { const bf16* kp = QKV + (size_t)(M_LAT + b * CL + c) * NQKV;
        const float s = dot64(q, kp + C_AK + 64 * h); osm_step(s, kp + C_AV + 64 * h, mx, l, acc); }
    store64(O + (size_t)m * D + 64 * h, acc, 1.0f / l);
}
HDF void diff_body(const bf16* QKV, float* OB, int m, int h, int i, int vh) {
    bool isctx; int b, t; row_decode(m, isctx, b, t);
    float q[64], acc[64]; load64(QKV + (size_t)m * NQKV + C_BQ + 64 * (2 * h + i), q);
#pragma unroll
    for (int d = 0; d < 64; ++d) acc[d] = 0.f;
    float mx = -INFINITY, l = 0.f;
    const int ko = C_BK + 64 * (2 * h + i), vo = C_BV + 128 * h + 64 * vh;
    if (!isctx) for (int j = 0; j < S; ++j) { const bf16* kp = QKV + (size_t)(b * S + j) * NQKV; osm_step(dot64(q, kp + ko), kp + vo, mx, l, acc); }
    for (int c = 0; c < CL; ++c) { const bf16* kp = QKV + (size_t)(M_LAT + b * CL + c) * NQKV; osm_step(dot64(q, kp + ko), kp + vo, mx, l, acc); }
    float* o = OB + ((size_t)(m * DFH + h) * 2 + i) * 128 + vh * 64; const float il = 1.0f / l;
#pragma unroll
    for (int d = 0; d < 64; ++d) o[d] = acc[d] * il;
}
HDF void diff_fin_body(const float* OB, bf16* O, int m, int h, float lam, float lam_init, const LayerP& P) {
    const float* o0 = OB + (size_t)(m * DFH + h) * 256; const float* o1 = o0 + 128;
    float ss = 0.f;
    for (int e = 0; e < 128; ++e) { const float v = o0[e] - lam * o1[e]; ss += v * v; }
    const float r = (1.0f / sqrtf(ss * (1.f / 128.f) + NORM_EPS)) * (1.0f - lam_init);
    bf16* op = O + (size_t)m * D + MIXW + 128 * h;
    for (int e = 0; e < 128; ++e) { const float v = o0[e] - lam * o1[e]; op[e] = (bf16)f2bf(v * r * P.subln[e]); }
}
HDF void swa_body(const bf16* QKV, bf16* O, int m, int hq, const LayerP& P) {
    bool isctx; int b, t; row_decode(m, isctx, b, t);
    const int kv = hq / SG;
    float q[64], acc[64]; load64(QKV + (size_t)m * NQKV + C_SQ + 64 * hq, q);
#pragma unroll
    for (int d = 0; d < 64; ++d) acc[d] = 0.f;
    float mx = -INFINITY, l = 0.f;
    const int ko = C_SK + 64 * kv, vo = C_SV + 64 * kv;
    if (!isctx) { int j0 = t - SWW; if (j0 < 0) j0 = 0; int j1 = t + SWW; if (j1 > S - 1) j1 = S - 1;
        for (int j = j0; j <= j1; ++j) { const bf16* kp = QKV + (size_t)(b * S + j) * NQKV; osm_step(dot64(q, kp + ko), kp + vo, mx, l, acc); } }
    for (int c = 0; c < CL; ++c) { const bf16* kp = QKV + (size_t)(M_LAT + b * CL + c) * NQKV; osm_step(dot64(q, kp + ko), kp + vo, mx, l, acc); }
    { const float s = P.sink[hq];
        if (s > mx) { const float c = FEXP(mx - s); l *= c;
#pragma unroll
            for (int d = 0; d < 64; ++d) acc[d] *= c;
            mx = s; }
        l += FEXP(s - mx); }
    store64(O + (size_t)m * D + 2 * MIXW + 64 * hq, acc, 1.0f / l);
}

#ifndef HOST_EMU
#define GAS __attribute__((address_space(1)))
#define LAS __attribute__((address_space(3)))
typedef unsigned v4u __attribute__((ext_vector_type(4)));
typedef float f32x4 __attribute__((ext_vector_type(4)));
typedef short bf16x8 __attribute__((ext_vector_type(8)));
typedef unsigned u32x4 __attribute__((ext_vector_type(4)));

constexpr size_t MiB = 1u << 20;
constexpr size_t al(size_t x) { return (x + MiB - 1) / MiB * MiB; }
constexpr size_t WS_CTL = 0, CTL_ZERO_BYTES = 1 * MiB;
constexpr size_t WS_MISC = 1 * MiB;
constexpr size_t MISC_CACT = 0, MISC_RT = (size_t)(NB + 1) * D * 4, MISC_LAM = MISC_RT + 64 * 16 * 8;
constexpr size_t WS_MODV = 2 * MiB;
constexpr size_t WS_CTXR = WS_MODV + al((size_t)NL * (NB + 1) * 6 * D * 4);
constexpr size_t WS_WIN = WS_CTXR + al((size_t)M_CTX * D * 4);
constexpr size_t WS_WBR = WS_WIN + al((size_t)PROJW * D * 2);
constexpr size_t WS_WOUT = WS_WBR + al((size_t)4 * D * MIXW * 2);
constexpr size_t WS_WGU = WS_WOUT + al((size_t)D * D * 2);
constexpr size_t WS_WD = WS_WGU + al((size_t)2 * DFF * D * 2);
constexpr size_t WS_H = WS_WD + al((size_t)D * DFF * 2);
constexpr size_t WS_QKV = WS_H + al((size_t)MT * D * 2);
constexpr size_t WS_GATES = WS_QKV + al((size_t)MT * NQKV * 2);
constexpr size_t WS_DPOOL = WS_GATES + al((size_t)MT * NGATE * 2);
constexpr size_t WS_O = WS_DPOOL + al((size_t)MT * MIXW * 2);
constexpr size_t WS_TMP = WS_O + al((size_t)MT * D * 2);
constexpr size_t WS_VT = WS_TMP + (size_t)256 * 256 * 256 * 4;
constexpr size_t WS_XB = WS_TMP;
constexpr size_t WS_END0 = WS_VT + al((size_t)(2 * MIXW + SKV * HDIM) * MT * 2);
constexpr size_t WS_END1 = (WS_XB + al((size_t)MT * D * 2)) > WS_END0 ? (WS_XB + al((size_t)MT * D * 2)) : WS_END0;
constexpr size_t WS_W2 = WS_END1;
constexpr size_t WS_WSET = WS_H - WS_WBR;
constexpr size_t WS_END = WS_W2 + WS_WSET;
static_assert((size_t)MT * DFF * 2 <= (size_t)MT * NGATE * 2, "HID fits in GATES");
static_assert((size_t)MT * DFH * 2 * 128 * 4 <= al((size_t)MT * D * 2), "OB fits in H");
static_assert(MISC_LAM + 64 + NL * 192 * 4 <= MiB, "misc");
constexpr int CW_BAR = 4096;

constexpr int RING_BYTES = 131072, LDSCTL_OFF = RING_BYTES, MISC_OFF = LDSCTL_OFF + 320, LDS_BYTES = 147456;
constexpr int NWAVES = 8, NTHR = 512;

#define LDS_WAIT() asm volatile("s_waitcnt lgkmcnt(0)" ::: "memory")
#define VM_WAIT() asm volatile("s_waitcnt vmcnt(0)" ::: "memory")

#define XB_TMO      128
#define XB_XCNT(j)  (256  + 64 * (j))
#define XB_XSUB(j)  (1280 + 64 * (j))
#define XB_XGEN(j)  (2304 + 64 * (j))
#define XB_TOP      3328
#define XB_TOPGEN   3392
#define XCD_BAR_WORDS 3456
#define XB_SPIN_CAP (1u << 21)
__device__ __forceinline__ unsigned xb_ld(unsigned* p)              { return __hip_atomic_load(p, __ATOMIC_RELAXED, __HIP_MEMORY_SCOPE_AGENT); }
__device__ __forceinline__ unsigned xb_add(unsigned* p, unsigned v) { return __hip_atomic_fetch_add(p, v, __ATOMIC_RELAXED, __HIP_MEMORY_SCOPE_AGENT); }
__device__ __forceinline__ unsigned xb_xcc_id() { return (unsigned)__builtin_amdgcn_s_getreg((3 << 11) | 20) & 0xFu; }
#define XB_SPIN(cond, bar) do { unsigned _sp = 0; while (cond) { __builtin_amdgcn_s_sleep(1); \
    if ((++_sp & 255u) == 0u) { if (xb_ld(&(bar)[XB_TMO])) break; if (_sp > XB_SPIN_CAP) { atomicAdd(&(bar)[XB_TMO], 1u); break; } } } } while (0)
struct XcdBarrier { unsigned* bar; unsigned x; volatile LAS unsigned* st; };
__device__ __forceinline__ XcdBarrier xcd_barrier_post(unsigned* bar, volatile LAS unsigned* st) {
    XcdBarrier b; b.bar = bar; b.x = xb_xcc_id(); b.st = st;
    if (threadIdx.x == 0) (void)xb_add(&bar[XB_XCNT(b.x)], 1u);
    return b;
}
__device__ __forceinline__ void xcd_barrier_complete(unsigned* bar, unsigned x, unsigned& nloc, unsigned& nx) {
    const unsigned G = gridDim.x * gridDim.y * gridDim.z;
    unsigned sum, cnt, mine, sp = 0u;
    for (;;) {
        sum = 0u; cnt = 0u; mine = 0u;
#pragma unroll
        for (unsigned j = 0; j < 16; ++j) { const unsigned c = xb_ld(&bar[XB_XCNT(j)]); sum += c; cnt += (c > 0u) ? 1u : 0u; mine = (j == x) ? c : mine; }
        if (sum == G) break;
        __builtin_amdgcn_s_sleep(1);
        if ((++sp & 255u) == 0u) { if (xb_ld(&bar[XB_TMO])) break; if (sp > XB_SPIN_CAP) { atomicAdd(&bar[XB_TMO], 1u); break; } }
    }
    nloc = mine > 0u ? mine : 1u; nx = cnt > 0u ? cnt : 1u;
}
__device__ __forceinline__ void xcd_barrier(const XcdBarrier& b) {
    asm volatile("s_waitcnt vmcnt(0)" ::: "memory");
    __syncthreads();
    if (threadIdx.x == 0) {
        unsigned* bar = b.bar;
        __builtin_amdgcn_s_waitcnt(0);
        unsigned nloc = b.st[0], nx = b.st[1];
        if (nloc == 0u) { xcd_barrier_complete(bar, b.x, nloc, nx); b.st[0] = nloc; b.st[1] = nx; }
        const unsigned old = xb_add(&bar[XB_XSUB(b.x)], 1u);
        const unsigned gen = old / nloc;
        if (old + 1u == (gen + 1u) * nloc) {
            __builtin_amdgcn_fence(__ATOMIC_RELEASE, "agent");
            asm volatile("s_waitcnt vmcnt(0)" ::: "memory");
            const unsigned og = xb_add(&bar[XB_TOP], 1u);
            const unsigned tg = og / nx;
            if (og + 1u == (tg + 1u) * nx) xb_add(&bar[XB_TOPGEN], 1u);
            else XB_SPIN(xb_ld(&bar[XB_TOPGEN]) == tg, bar);
            __builtin_amdgcn_fence(__ATOMIC_ACQUIRE, "agent");
            xb_add(&bar[XB_XGEN(b.x)], 1u);
            asm volatile("s_waitcnt vmcnt(0)" ::: "memory");
        } else {
            XB_SPIN(xb_ld(&bar[XB_XGEN(b.x)]) == gen, bar);
            __builtin_amdgcn_fence(__ATOMIC_ACQUIRE, "agent");
            asm volatile("s_waitcnt vmcnt(0)" ::: "memory");
        }
    }
    __syncthreads();
}

namespace pg8 {
constexpr int BM = 256, BK = 64, HALF = 128, HTB = HALF * BK * 2, NXCD = 8, WGM = 4;
__host__ __device__ __forceinline__ int lds_byte(int r, int c) { const int st = (r >> 4) * 2 + (c >> 5), rr = r & 15, cc = c & 31, ob = rr * 64 + cc * 2; return st * 1024 + (ob ^ (((ob >> 9) & 1) << 5)); }
__host__ __device__ __forceinline__ void stage_rc(int b, int& R, int& C) { const int st = b / 1024, sb = b % 1024, swz = sb ^ (((sb >> 9) & 1) << 5); R = (st >> 1) * 16 + swz / 64; C = (st & 1) * 32 + (swz % 64) / 2; }
__host__ __device__ __forceinline__ int perm32(int rho) { const int n = rho >> 4, i = rho & 15; return 8 * (i >> 2) + 4 * n + (i & 3); }

struct Unit { int pm, pn, tag, half; };
struct Gemm { const bf16* A; const bf16* Bt; int lda, ldb, K; };

__device__ __forceinline__ void rect_unit(int L, int nM, int nN, int& pm, int& pn) {
    const int nwg = nM * nN; int wgid = L;
    { const int q = nwg / NXCD, r = nwg % NXCD, xcd = wgid % NXCD, off = wgid / NXCD; wgid = (xcd < r ? xcd * (q + 1) : r * (q + 1) + (xcd - r) * q) + off; }
    const int nig = WGM * nN, gid = wgid / nig, fm = gid * WGM, gsz = (nM - fm) < WGM ? (nM - fm) : WGM;
    pm = fm + ((wgid % nig) % gsz); pn = (wgid % nig) / gsz;
}
struct Sched {
    int nM0, nN0, nM1, nN1, sub, G, c;
    size_t bsub;
    int asub;
    int rev;
    int ksplit;
    __device__ __forceinline__ bool next(int i, Unit& u) const {
        const int j = i / sub, tg = i - j * sub; long L = (long)j * G + c; const int n0 = nM0 * nN0, n1 = nM1 * nN1 * (ksplit ? 2 : 1);
        if (L >= n0 + n1) return false;
        if (rev) L = (long)(n0 + n1 - 1) - L;
        u.tag = tg; u.half = 0;
        if (L < n0) rect_unit((int)L, nM0, nN0, u.pm, u.pn);
        else if (!ksplit) { rect_unit((int)L - n0, nM1, nN1, u.pm, u.pn); u.pm += nM0; }
        else { rect_unit((int)L - n0, nM1, 2 * nN1, u.pm, u.pn); u.pm += nM0; u.half = 1; u.tag = u.pn >= nN1 ? 1 : 0; u.pn -= u.tag * nN1; }
        return true;
    }
    __device__ __forceinline__ size_t aoff(const Unit& u, int lda) const { return (size_t)u.pm * 256 * lda + (size_t)u.tag * asub; }
    __device__ __forceinline__ size_t boff(const Unit& u, int ldb) const { return (size_t)u.pn * 256 * ldb + (size_t)u.tag * bsub; }
};

template <class Epi>
__device__ __forceinline__ void gemm_phase(LAS unsigned char* lds, const Gemm g, const Sched& S, const Epi& E) {
    int tid_ = threadIdx.x; asm volatile("" : "+v"(tid_));
    const int tid = tid_, wid = __builtin_amdgcn_readfirstlane(tid >> 6), lane = tid & 63, wr = wid >> 2, wc = wid & 3, fr = lane & 15, fq = lane >> 4;
    const int K = g.K, nt = K / BK;
    unsigned voffA[2], voffB[2];
#pragma unroll
    for (int i = 0; i < 2; ++i) { int R, C; stage_rc(tid * 16 + i * 8192, R, C); const int Rb = (R & ~31) + perm32(R & 31);
        voffA[i] = (unsigned)(R * g.lda + C) * 2u; voffB[i] = (unsigned)(Rb * g.ldb + C) * 2u; }
    const size_t kstep = (size_t)(BK * 2);
    const size_t hstepA = (size_t)HALF * g.lda * 2, hstepB = (size_t)HALF * g.ldb * 2;
    const unsigned ldsw = (unsigned)wid * 1024u;
    const int aoff = lds_byte(wr * 64 + fr, fq * 8), boff = lds_byte(wc * 32 + fr, fq * 8);
#define PG8_SA(b, h) (((b) * 2 + (h)) * HTB)
#define PG8_SB(b, h) ((4 + (b) * 2 + (h)) * HTB)
#define PG8_STAGE(bufoff, gbase, voff) do { _Pragma("unroll") for (int _i = 0; _i < 2; ++_i) \
        __builtin_amdgcn_global_load_lds((const unsigned*)((const char*)(gbase) + (voff)[_i]), (LAS unsigned*)(lds + (bufoff) + ldsw + _i * 8192), 16, 0, 0); } while (0)
#define PG8_LDA(dst, b, h) do { _Pragma("unroll") for (int m = 0; m < 4; ++m) _Pragma("unroll") for (int k = 0; k < 2; ++k) dst[m][k] = *(const LAS bf16x8*)(lds + PG8_SA(b, h) + aoff + m * 2048 + k * 1024); } while (0)
#define PG8_LDB(dst, b, h) do { _Pragma("unroll") for (int n = 0; n < 2; ++n) _Pragma("unroll") for (int k = 0; k < 2; ++k) dst[n][k] = *(const LAS bf16x8*)(lds + PG8_SB(b, h) + boff + n * 2048 + k * 1024); } while (0)
#define PG8_MMA(ai, bj, At, Bt) do { __builtin_amdgcn_s_setprio(1); _Pragma("unroll") for (int m = 0; m < 4; ++m) _Pragma("unroll") for (int n = 0; n < 2; ++n) _Pragma("unroll") for (int k = 0; k < 2; ++k) \
        acc[ai][bj][m][n] = __builtin_amdgcn_mfma_f32_16x16x32_bf16(Bt[n][k], At[m][k], acc[ai][bj][m][n], 0, 0, 0); __builtin_amdgcn_s_setprio(0); } while (0)
#define PG8_WAIT_V(n) asm volatile("s_waitcnt vmcnt(" #n ")" ::: "memory")
#define PG8_WAIT_L(n) asm volatile("s_waitcnt lgkmcnt(" #n ")" ::: "memory")
#define PG8_BAR __builtin_amdgcn_s_barrier()
#define PG8_SCHED __builtin_amdgcn_sched_barrier(0)
    Unit cur, nxt; int ui = 0;
    if (!S.next(0, cur)) return;
    f32x4 acc[2][2][4][2];
#pragma unroll
    for (int a = 0; a < 2; ++a)
#pragma unroll
        for (int b = 0; b < 2; ++b)
#pragma unroll
            for (int m = 0; m < 4; ++m)
#pragma unroll
                for (int n = 0; n < 2; ++n) acc[a][b][m][n] = (f32x4){0.f, 0.f, 0.f, 0.f};
    bf16x8 At[4][2], B0[2][2], B1[2][2];
    const char* cA = (const char*)(g.A + S.aoff(cur, g.lda)); const char* cB = (const char*)(g.Bt + S.boff(cur, g.ldb));
    PG8_STAGE(PG8_SB(0, 0), cB, voffB); PG8_STAGE(PG8_SB(0, 1), cB + hstepB, voffB); PG8_STAGE(PG8_SA(0, 0), cA, voffA); PG8_STAGE(PG8_SA(0, 1), cA + hstepA, voffA);
    if (wr == 1) PG8_BAR;
    PG8_WAIT_V(2); PG8_BAR;
    PG8_STAGE(PG8_SB(1, 0), cB + kstep, voffB); PG8_STAGE(PG8_SA(1, 0), cA + kstep, voffA); PG8_STAGE(PG8_SB(1, 1), cB + hstepB + kstep, voffB);
    PG8_WAIT_V(6); PG8_BAR;
    for (;;) {
        const bool has_next = S.next(ui + 1, nxt);
        const char* nA = has_next ? (const char*)(g.A + S.aoff(nxt, g.lda)) : cA; const char* nB = has_next ? (const char*)(g.Bt + S.boff(nxt, g.ldb)) : cB;
        const int ntu = cur.half ? nt >> 1 : nt;
        for (int t = 0; t < ntu; t += 2) {
            const bool last = (t == ntu - 2);
            const char* a1 = cA + (size_t)(t + 1) * kstep;
            const char* a2 = last ? nA : cA + (size_t)(t + 2) * kstep; const char* b2 = last ? nB : cB + (size_t)(t + 2) * kstep;
            const char* a3 = a2 + kstep; const char* b3 = b2 + kstep;
            PG8_LDB(B0, 0, 0); PG8_LDB(B1, 0, 1); PG8_SCHED; PG8_LDA(At, 0, 0); PG8_STAGE(PG8_SA(1, 1), a1 + hstepA, voffA);
            PG8_WAIT_V(8); PG8_WAIT_L(0); PG8_BAR; PG8_MMA(0, 0, At, B0); PG8_MMA(0, 1, At, B1); PG8_BAR; PG8_SCHED;
            PG8_LDA(At, 0, 1); PG8_STAGE(PG8_SB(0, 0), b2, voffB); PG8_STAGE(PG8_SB(0, 1), b2 + hstepB, voffB); PG8_STAGE(PG8_SA(0, 0), a2, voffA);
            PG8_WAIT_V(8); PG8_WAIT_L(0); PG8_BAR; PG8_MMA(1, 0, At, B0); PG8_MMA(1, 1, At, B1); PG8_BAR; PG8_SCHED;
            PG8_LDB(B0, 1, 0); PG8_LDB(B1, 1, 1); PG8_SCHED; PG8_LDA(At, 1, 0); PG8_STAGE(PG8_SA(0, 1), a2 + hstepA, voffA);
            PG8_WAIT_V(8); PG8_WAIT_L(0); PG8_BAR; PG8_MMA(0, 0, At, B0); PG8_MMA(0, 1, At, B1); PG8_BAR; PG8_SCHED;
            PG8_LDA(At, 1, 1); PG8_STAGE(PG8_SB(1, 0), b3, voffB); PG8_STAGE(PG8_SB(1, 1), b3 + hstepB, voffB); PG8_STAGE(PG8_SA(1, 0), a3, voffA);
            PG8_WAIT_V(8); PG8_WAIT_L(0); PG8_BAR; PG8_MMA(1, 0, At, B0); PG8_MMA(1, 1, At, B1); PG8_BAR; PG8_SCHED;
        }
        if (wr == 0) PG8_BAR;
        E(acc, cur, wr, wc, fr, fq);
        if (!has_next) break;
#pragma unroll
        for (int a = 0; a < 2; ++a)
#pragma unroll
            for (int b = 0; b < 2; ++b)
#pragma unroll
                for (int m = 0; m < 4; ++m)
#pragma unroll
                    for (int n = 0; n < 2; ++n) acc[a][b][m][n] = (f32x4){0.f, 0.f, 0.f, 0.f};
        cur = nxt; cA = nA; cB = nB; ++ui;
        if (wr == 1) PG8_BAR;
    }
    PG8_WAIT_V(0);
    PG8_BAR;
#undef PG8_SA
#undef PG8_SB
#undef PG8_STAGE
#undef PG8_LDA
#undef PG8_LDB
#undef PG8_MMA
#undef PG8_WAIT_V
#undef PG8_WAIT_L
#undef PG8_BAR
#undef PG8_SCHED
}
}

__device__ __forceinline__ unsigned cvt_pk(float lo, float hi) { unsigned r; asm volatile("v_cvt_pk_bf16_f32 %0, %1, %2" : "=v"(r) : "v"(lo), "v"(hi)); return r; }
__device__ __forceinline__ float sigm(float x) { return __builtin_amdgcn_rcpf(1.0f + __expf(-x)); }

__host__ __device__ constexpr bool is_ktile(int pn) { return pn == C_AK / 256 || pn == C_AK / 256 + 1 || pn == C_BK / 256 || pn == C_BK / 256 + 1 || pn == C_SK / 256; }
__host__ __device__ constexpr int kperm_row(int n0) { return is_ktile(n0 / 256) ? (n0 & ~255) + (((n0 & 63) >> 5) * 128) + (((n0 & 255) >> 6) * 32) + (n0 & 31) : n0; }
static_assert(C_AK % 256 == 0 && C_BK % 256 == 0 && C_SK % 256 == 0 && MIXW == 512 && SKV * HDIM == 128, "k tile geometry");
using u32x2 = __attribute__((ext_vector_type(2))) unsigned;
__device__ __forceinline__ unsigned pk4u8(float a, float b, float c, float d) {
    const unsigned ua = __builtin_bit_cast(unsigned, fmaf(a, 255.f, 8388608.f)), ub = __builtin_bit_cast(unsigned, fmaf(b, 255.f, 8388608.f));
    const unsigned uc = __builtin_bit_cast(unsigned, fmaf(c, 255.f, 8388608.f)), ud = __builtin_bit_cast(unsigned, fmaf(d, 255.f, 8388608.f));
    const unsigned lo = __builtin_amdgcn_perm(ub, ua, 0x0c0c0400u), hi = __builtin_amdgcn_perm(ud, uc, 0x0c0c0400u);
    return __builtin_amdgcn_perm(hi, lo, 0x05040100u);
}
__device__ __forceinline__ f32x4 u8x4f(unsigned u) { return (f32x4){(float)(u & 0xffu), (float)((u >> 8) & 0xffu), (float)((u >> 16) & 0xffu), (float)(u >> 24)}; }
struct EpiWin {
    bf16* QKV; unsigned char* GATES; const float* kg; const F2* RT;
    __device__ __forceinline__ void operator()(const f32x4 (&acc)[2][2][4][2], const pg8::Unit& u, int wr, int wc, int fr, int fq) const {
        const bool isg = u.pn >= NQKV / 256;
        const int row0 = u.pm * 256 + wr * 64 + fr;
        if (!isg && is_ktile(u.pn)) {
            const bool sk = u.pn == C_SK / 256; const bool norm = !sk || wc < 2;
            const bool rope = u.pn != C_AK / 256 && u.pn != C_AK / 256 + 1 && norm && u.pm * 256 < M_LAT;
            const float* g = kg + ((u.pn == C_AK / 256 || u.pn == C_AK / 256 + 1) ? 0 : (sk ? 128 : 64));
            f32x4 gv[2][2];
#pragma unroll
            for (int bj = 0; bj < 2; ++bj)
#pragma unroll
                for (int n = 0; n < 2; ++n) gv[bj][n] = *(const f32x4*)(g + 32 * bj + 8 * fq + 4 * n);
            const int colk = u.pn * 256 + 64 * wc + 8 * fq;
#pragma unroll
            for (int ai = 0; ai < 2; ++ai)
#pragma unroll
                for (int m = 0; m < 4; ++m) { const int row = row0 + ai * 128 + m * 16;
                    f32x4 x[2][2]; float ss = 0.f;
#pragma unroll
                    for (int bj = 0; bj < 2; ++bj)
#pragma unroll
                        for (int n = 0; n < 2; ++n) { x[bj][n] = acc[ai][bj][m][n]; ss += (x[bj][n].x * x[bj][n].x + x[bj][n].y * x[bj][n].y) + (x[bj][n].z * x[bj][n].z + x[bj][n].w * x[bj][n].w); }
                    ss += __shfl_xor(ss, 16); ss += __shfl_xor(ss, 32);
                    const float rs = norm ? 1.0f / sqrtf(ss * (1.f / 64.f) + NORM_EPS) : 1.0f;
#pragma unroll
                    for (int bj = 0; bj < 2; ++bj)
#pragma unroll
                        for (int n = 0; n < 2; ++n) { if (norm) x[bj][n] = x[bj][n] * rs * gv[bj][n]; }
                    if (rope) { const int t = row % S; const bool hi = fq >= 2;
#pragma unroll
                        for (int bj = 0; bj < 2; ++bj) { const int pos = bj == 0 ? t / GW : t % GW;
#pragma unroll
                            for (int n = 0; n < 2; ++n)
#pragma unroll
                                for (int j = 0; j < 4; ++j) { const float own = x[bj][n][j], o = __shfl_xor(own, 32); const F2 cs = RT[pos * 16 + 8 * (fq & 1) + 4 * n + j];
                                    x[bj][n][j] = hi ? own * cs.x + o * cs.y : own * cs.x - o * cs.y; } } }
                    bf16* rowp = QKV + (size_t)row * NQKV + colk;
#pragma unroll
                    for (int bj = 0; bj < 2; ++bj) { u32x4 w; w.x = cvt_pk(x[bj][0][0], x[bj][0][1]); w.y = cvt_pk(x[bj][0][2], x[bj][0][3]); w.z = cvt_pk(x[bj][1][0], x[bj][1][1]); w.w = cvt_pk(x[bj][1][2], x[bj][1][3]);
                        *(u32x4*)(rowp + 32 * bj) = w; } }
            return;
        }
        if (isg) {
            const int colt = (u.pn - NQKV / 256) * 256 + wc * 32 + 8 * fq;
#pragma unroll
            for (int ai = 0; ai < 2; ++ai)
#pragma unroll
                for (int m = 0; m < 4; ++m) { unsigned char* rowp = GATES + (size_t)(row0 + ai * 128 + m * 16) * NGATE + colt;
#pragma unroll
                    for (int bj = 0; bj < 2; ++bj) { const f32x4 v0 = acc[ai][bj][m][0], v1 = acc[ai][bj][m][1];
                        u32x2 w; w.x = pk4u8(sigm(v0[0]), sigm(v0[1]), sigm(v0[2]), sigm(v0[3])); w.y = pk4u8(sigm(v1[0]), sigm(v1[1]), sigm(v1[2]), sigm(v1[3]));
                        *(u32x2*)(rowp + bj * 128) = w; } }
            return;
        }
        const int colt = u.pn * 256 + wc * 32 + 8 * fq;
#pragma unroll
        for (int ai = 0; ai < 2; ++ai)
#pragma unroll
            for (int m = 0; m < 4; ++m) { bf16* rowp = QKV + (size_t)(row0 + ai * 128 + m * 16) * NQKV + colt;
#pragma unroll
                for (int bj = 0; bj < 2; ++bj) { const f32x4 v0 = acc[ai][bj][m][0], v1 = acc[ai][bj][m][1];
                    u32x4 w; w.x = cvt_pk(v0[0], v0[1]); w.y = cvt_pk(v0[2], v0[3]); w.z = cvt_pk(v1[0], v1[1]); w.w = cvt_pk(v1[2], v1[3]);
                    *(u32x4*)(rowp + bj * 128) = w; } }
    }
};
struct EpiMerge {
    const bf16* GATES; bf16* ACC; u32x4* TMP;
    template <int MODE>
    __device__ __forceinline__ void run(const f32x4 (&acc)[2][2][4][2], const pg8::Unit& u, int wr, int wc, int fr, int fq) const {
        const int n = u.tag, row0 = u.pm * 256 + wr * 64 + fr, colt = u.pn * 256 + wc * 32 + 8 * fq; const int tid = threadIdx.x;
        const bf16* gp = GATES + (size_t)row0 * NGATE + (size_t)n * D + colt;
        bf16* ap = ACC + (size_t)row0 * D + colt;
        u32x4* tp = TMP + tid;
#pragma unroll
        for (int ai = 0; ai < 2; ++ai)
#pragma unroll
            for (int mp = 0; mp < 2; ++mp) {
                asm volatile("" : "+v"(gp), "+v"(ap), "+v"(tp) :: "memory");
                u32x4 gq[2][2], tv[2][2];
#pragma unroll
                for (int mm = 0; mm < 2; ++mm)
#pragma unroll
                    for (int bj = 0; bj < 2; ++bj) { gq[mm][bj] = *(const u32x4*)(gp + (size_t)mm * 16 * NGATE + bj * 128);
                        if (MODE > 0) tv[mm][bj] = tp[(mm * 2 + bj) * NTHR]; }
#pragma unroll
                for (int mm = 0; mm < 2; ++mm)
#pragma unroll
                    for (int bj = 0; bj < 2; ++bj) { const int m = mp * 2 + mm; const u32x4 g4 = gq[mm][bj];
                        f32x4 v0 = acc[ai][bj][m][0] * (f32x4){bflo(g4.x), bfhi(g4.x), bflo(g4.y), bfhi(g4.y)}, v1 = acc[ai][bj][m][1] * (f32x4){bflo(g4.z), bfhi(g4.z), bflo(g4.w), bfhi(g4.w)};
                        if (MODE > 0) { const u32x4 t4 = tv[mm][bj]; v0 += (f32x4){bflo(t4.x), bfhi(t4.x), bflo(t4.y), bfhi(t4.y)}; v1 += (f32x4){bflo(t4.z), bfhi(t4.z), bflo(t4.w), bfhi(t4.w)}; }
                        u32x4 w; w.x = cvt_pk(v0[0], v0[1]); w.y = cvt_pk(v0[2], v0[3]); w.z = cvt_pk(v1[0], v1[1]); w.w = cvt_pk(v1[2], v1[3]);
                        if (MODE < 2) tp[(mm * 2 + bj) * NTHR] = w;
                        else *(u32x4*)(ap + (size_t)mm * 16 * D + bj * 128) = w; }
                gp += (size_t)(mp == 1 ? 128 - 32 : 32) * NGATE; ap += (size_t)(mp == 1 ? 128 - 32 : 32) * D; tp += 4 * NTHR;
            }
    }
    __device__ __forceinline__ void operator()(const f32x4 (&acc)[2][2][4][2], const pg8::Unit& u, int wr, int wc, int fr, int fq) const {
        if (u.tag == 0) run<0>(acc, u, wr, wc, fr, fq); else if (u.tag == 3) run<2>(acc, u, wr, wc, fr, fq); else run<1>(acc, u, wr, wc, fr, fq);
    }
};
struct EpiResid {
    bf16* xb; float* outf; float* pb; const float* modv; int chunk;
    __device__ __forceinline__ void operator()(const f32x4 (&acc)[2][2][4][2], const pg8::Unit& u, int wr, int wc, int fr, int fq) const {
        const int prow = u.pm * 256; const bool isctx = prow >= M_LAT;
        const int mrow = isctx ? NB : prow / S;
        const int row0 = prow + wr * 64 + fr, colt = u.pn * 256 + wc * 32 + 8 * fq;
        const float* gp = modv + (size_t)mrow * 6 * D + (size_t)chunk * D + colt;
        f32x4 gv[2][2];
#pragma unroll
        for (int bj = 0; bj < 2; ++bj)
#pragma unroll
            for (int n = 0; n < 2; ++n) gv[bj][n] = *(const f32x4*)(gp + bj * 128 + 4 * n);
        if (u.half && u.tag) {
            float* pp = pb + (size_t)(row0 - M_LAT) * D + colt;
#pragma unroll
            for (int ai = 0; ai < 2; ++ai)
#pragma unroll
                for (int m = 0; m < 4; ++m)
#pragma unroll
                    for (int bj = 0; bj < 2; ++bj) { float* q = pp + (size_t)(ai * 128 + m * 16) * D + bj * 128;
                        f32x4 g0 = gv[bj][0], g1 = gv[bj][1]; asm volatile("" : "+v"(g0), "+v"(g1));
                        *(f32x4*)q = g0 * acc[ai][bj][m][0]; *(f32x4*)(q + 4) = g1 * acc[ai][bj][m][1]; }
            return;
        }
        bf16* sp = xb + (size_t)row0 * D + colt; float* dp = outf + (size_t)row0 * D + colt;
        const bool tof = outf != nullptr;
#pragma unroll
        for (int ai = 0; ai < 2; ++ai)
#pragma unroll
            for (int mp = 0; mp < 2; ++mp) {
                asm volatile("" : "+v"(sp), "+v"(dp) :: "memory");
                u32x4 sv[2][2];
#pragma unroll
                for (int mm = 0; mm < 2; ++mm)
#pragma unroll
                    for (int bj = 0; bj < 2; ++bj) sv[mm][bj] = *(const u32x4*)(sp + (size_t)mm * 16 * D + bj * 128);
#pragma unroll
                for (int mm = 0; mm < 2; ++mm)
#pragma unroll
                    for (int bj = 0; bj < 2; ++bj) {
                        const u32x4 s4 = sv[mm][bj];
                        f32x4 r0 = gv[bj][0] * acc[ai][bj][mp * 2 + mm][0], r1 = gv[bj][1] * acc[ai][bj][mp * 2 + mm][1];
                        r0.x += bflo(s4.x); r0.y += bfhi(s4.x); r0.z += bflo(s4.y); r0.w += bfhi(s4.y);
                        r1.x += bflo(s4.z); r1.y += bfhi(s4.z); r1.z += bflo(s4.w); r1.w += bfhi(s4.w);
                        if (tof) { *(f32x4*)(dp + (size_t)mm * 16 * D + bj * 128) = r0; *(f32x4*)(dp + (size_t)mm * 16 * D + bj * 128 + 4) = r1; }
                        else { u32x4 w; w.x = pk2(r0.x, r0.y); w.y = pk2(r0.z, r0.w); w.z = pk2(r1.x, r1.y); w.w = pk2(r1.z, r1.w); *(u32x4*)(sp + (size_t)mm * 16 * D + bj * 128) = w; }
                    }
                sp += (size_t)(mp == 1 ? 128 - 32 : 32) * D; dp += (size_t)(mp == 1 ? 128 - 32 : 32) * D;
            }
    }
};
struct EpiFfnUp {
    bf16* HID;
    __device__ __forceinline__ void operator()(const f32x4 (&acc)[2][2][4][2], const pg8::Unit& u, int wr, int wc, int fr, int fq) const {
        const int row0 = u.pm * 256 + wr * 64 + fr, col = u.pn * 128 + wc * 32 + 8 * fq;
#pragma unroll
        for (int ai = 0; ai < 2; ++ai)
#pragma unroll
            for (int m = 0; m < 4; ++m) { bf16* rowp = HID + (size_t)(row0 + ai * 128 + m * 16) * DFF + col;
                f32x4 h[2];
#pragma unroll
                for (int n = 0; n < 2; ++n) { const f32x4 g = acc[ai][0][m][n], up = acc[ai][1][m][n];
                    h[n] = (f32x4){g[0] * sigm(g[0]) * up[0], g[1] * sigm(g[1]) * up[1], g[2] * sigm(g[2]) * up[2], g[3] * sigm(g[3]) * up[3]}; }
                u32x4 w; w.x = cvt_pk(h[0][0], h[0][1]); w.y = cvt_pk(h[0][2], h[0][3]); w.z = cvt_pk(h[1][0], h[1][1]); w.w = cvt_pk(h[1][2], h[1][3]);
                *(u32x4*)rowp = w; }
    }
};

namespace pg8 {
__device__ __forceinline__ void merge_phase(LAS unsigned char* lds, const bf16* Om, const bf16* WBR, const unsigned char* GATESp, bf16* ACCp, int nM, int G, int c) {
    int tid_ = threadIdx.x; asm volatile("" : "+v"(tid_));
    const int tid = tid_, wid = __builtin_amdgcn_readfirstlane(tid >> 6), lane = tid & 63, wr = wid >> 2, wc = wid & 3, fr = lane & 15, fq = lane >> 4;
    constexpr int K = MIXW, nt = K / BK, lda = D, ldb = MIXW, nN = D / 128;
    unsigned voffA[2], voffB[2];
#pragma unroll
    for (int i = 0; i < 2; ++i) { int R, C; stage_rc(tid * 16 + i * 8192, R, C); const int Rb = (R & ~31) + perm32(R & 31);
        voffA[i] = (unsigned)(R * lda + C) * 2u; voffB[i] = (unsigned)(Rb * ldb + C) * 2u; }
    const size_t kstep = (size_t)(BK * 2);
    const size_t hstepA = (size_t)HALF * lda * 2;
    const unsigned ldsw = (unsigned)wid * 1024u;
    const int aoff = lds_byte(wr * 64 + fr, fq * 8), boff = lds_byte(wc * 32 + fr, fq * 8);
    const int ntile = nM * nN;
#define MG_SA(b, h) (((b) * 2 + (h)) * HTB)
#define MG_SB(b) ((4 + (b)) * HTB)
#define MG_STAGE(bufoff, gbase, voff) do { _Pragma("unroll") for (int _i = 0; _i < 2; ++_i) \
        __builtin_amdgcn_global_load_lds((const unsigned*)((const char*)(gbase) + (voff)[_i]), (LAS unsigned*)(lds + (bufoff) + ldsw + _i * 8192), 16, 0, 0); } while (0)
#define MG_LDA(dst, b, h) do { _Pragma("unroll") for (int m = 0; m < 4; ++m) _Pragma("unroll") for (int k = 0; k < 2; ++k) dst[m][k] = *(const LAS bf16x8*)(lds + MG_SA(b, h) + aoff + m * 2048 + k * 1024); } while (0)
#define MG_LDB(dst, b) do { _Pragma("unroll") for (int n = 0; n < 2; ++n) _Pragma("unroll") for (int k = 0; k < 2; ++k) dst[n][k] = *(const LAS bf16x8*)(lds + MG_SB(b) + boff + n * 2048 + k * 1024); } while (0)
#define MG_MMA(ai) do { __builtin_amdgcn_s_setprio(1); _Pragma("unroll") for (int m = 0; m < 4; ++m) _Pragma("unroll") for (int n = 0; n < 2; ++n) _Pragma("unroll") for (int k = 0; k < 2; ++k) \
        acc[ai][m][n] = __builtin_amdgcn_mfma_f32_16x16x32_bf16(B0[n][k], At[m][k], acc[ai][m][n], 0, 0, 0); __builtin_amdgcn_s_setprio(0); } while (0)
#define MG_WAIT_V(n) asm volatile("s_waitcnt vmcnt(" #n ")" ::: "memory")
#define MG_WAIT_L(n) asm volatile("s_waitcnt lgkmcnt(" #n ")" ::: "memory")
#define MG_BAR __builtin_amdgcn_s_barrier()
#define MG_SCHED __builtin_amdgcn_sched_barrier(0)
    int ui = 0, pm, pn, tag = 0;
    if (c >= ntile) return;
    rect_unit(c, nM, nN, pm, pn);
    f32x4 acc[2][4][2], tot[2][4][2];
#pragma unroll
    for (int a = 0; a < 2; ++a)
#pragma unroll
        for (int m = 0; m < 4; ++m)
#pragma unroll
            for (int n = 0; n < 2; ++n) { acc[a][m][n] = (f32x4){0.f, 0.f, 0.f, 0.f}; tot[a][m][n] = (f32x4){0.f, 0.f, 0.f, 0.f}; }
    bf16x8 At[4][2], B0[2][2]; u32x2 gq[2][4];
    const char* cA = (const char*)(Om + (size_t)pm * 256 * lda); const char* cB = (const char*)(WBR + (size_t)pn * 128 * ldb);
    MG_STAGE(MG_SB(0), cB, voffB); MG_STAGE(MG_SA(0, 0), cA, voffA); MG_STAGE(MG_SA(0, 1), cA + hstepA, voffA);
    if (wr == 1) MG_BAR;
    MG_WAIT_V(2); MG_BAR;
    MG_STAGE(MG_SB(1), cB + kstep, voffB); MG_STAGE(MG_SA(1, 0), cA + kstep, voffA);
    MG_WAIT_V(4); MG_BAR;
    for (;;) {
        int npm = pm, npn = pn, ntag = tag + 1; bool has_next = true;
        if (ntag == 4) { ntag = 0; const long L = (long)((ui + 1) / 4) * G + c; if (L >= ntile) has_next = false; else rect_unit((int)L, nM, nN, npm, npn); }
        const char* nA = has_next ? (const char*)(Om + (size_t)npm * 256 * lda + (size_t)ntag * MIXW) : cA;
        const char* nB = has_next ? (const char*)(WBR + (size_t)ntag * D * MIXW + (size_t)npn * 128 * ldb) : cB;
        const unsigned char* gpp = GATESp + (size_t)(pm * 256 + wr * 64 + fr) * NGATE + (size_t)tag * D + pn * 128 + wc * 32 + 8 * fq;
        asm volatile("" : "+v"(gpp));
        for (int t = 0; t < nt; t += 2) {
            const bool last = (t == nt - 2);
            const char* a1 = cA + (size_t)(t + 1) * kstep;
            const char* a2 = last ? nA : cA + (size_t)(t + 2) * kstep; const char* b2 = last ? nB : cB + (size_t)(t + 2) * kstep;
            const char* a3 = a2 + kstep; const char* b3 = b2 + kstep;
            MG_LDB(B0, 0); MG_SCHED; MG_LDA(At, 0, 0); MG_STAGE(MG_SA(1, 1), a1 + hstepA, voffA);
            MG_WAIT_V(6); MG_WAIT_L(0); MG_BAR; MG_MMA(0); MG_BAR; MG_SCHED;
            MG_LDA(At, 0, 1);
            if (t == 2) {
#pragma unroll
                for (int a = 0; a < 2; ++a)
#pragma unroll
                    for (int m = 0; m < 4; ++m) { const unsigned char* gp_ = gpp + (size_t)(a * 128 + m * 16) * NGATE;
                        asm volatile("global_load_dwordx2 %0, %1, off" : "=&v"(gq[a][m]) : "v"(gp_) : "memory"); }
            }
            MG_STAGE(MG_SB(0), b2, voffB); MG_STAGE(MG_SA(0, 0), a2, voffA);
            MG_WAIT_V(6); MG_WAIT_L(0); MG_BAR; MG_MMA(1); MG_BAR; MG_SCHED;
            MG_LDB(B0, 1); MG_SCHED; MG_LDA(At, 1, 0); MG_STAGE(MG_SA(0, 1), a2 + hstepA, voffA);
            MG_WAIT_V(6); MG_WAIT_L(0); MG_BAR; MG_MMA(0); MG_BAR; MG_SCHED;
            MG_LDA(At, 1, 1); MG_STAGE(MG_SB(1), b3, voffB); MG_STAGE(MG_SA(1, 0), a3, voffA);
            MG_WAIT_V(6); MG_WAIT_L(0); MG_BAR; MG_MMA(1); MG_BAR; MG_SCHED;
        }
        if (wr == 0) MG_BAR;
        {
            const int row0 = pm * 256 + wr * 64 + fr, col = pn * 128 + wc * 32 + 8 * fq;
#pragma unroll
            for (int a = 0; a < 2; ++a)
#pragma unroll
                for (int m = 0; m < 4; ++m) { const u32x2 g2 = gq[a][m];
                    tot[a][m][0] += acc[a][m][0] * u8x4f(g2.x);
                    tot[a][m][1] += acc[a][m][1] * u8x4f(g2.y);
                    acc[a][m][0] = (f32x4){0.f, 0.f, 0.f, 0.f}; acc[a][m][1] = (f32x4){0.f, 0.f, 0.f, 0.f}; }
            if (tag == 3) {
                bf16* ap = ACCp + (size_t)row0 * D + col;
#pragma unroll
                for (int a = 0; a < 2; ++a)
#pragma unroll
                    for (int m = 0; m < 4; ++m) { const f32x4 v0 = tot[a][m][0] * (1.0f / 255.0f), v1 = tot[a][m][1] * (1.0f / 255.0f);
                        u32x4 w; w.x = cvt_pk(v0[0], v0[1]); w.y = cvt_pk(v0[2], v0[3]); w.z = cvt_pk(v1[0], v1[1]); w.w = cvt_pk(v1[2], v1[3]);
                        *(u32x4*)(ap + (size_t)(a * 128 + m * 16) * D) = w;
                        tot[a][m][0] = (f32x4){0.f, 0.f, 0.f, 0.f}; tot[a][m][1] = (f32x4){0.f, 0.f, 0.f, 0.f}; }
            }
        }
        if (!has_next) break;
        pm = npm; pn = npn; tag = ntag; cA = nA; cB = nB; ++ui;
        if (wr == 1) MG_BAR;
    }
    MG_WAIT_V(0);
    MG_BAR;
#undef MG_SA
#undef MG_SB
#undef MG_STAGE
#undef MG_LDA
#undef MG_LDB
#undef MG_MMA
#undef MG_WAIT_V
#undef MG_WAIT_L
#undef MG_BAR
#undef MG_SCHED
}
}

__device__ __forceinline__ float wave_sum(float v) {
#pragma unroll
    for (int o = 1; o < 64; o <<= 1) v += __shfl_xor(v, o);
    return v;
}
__device__ __forceinline__ void transpose_item(const float* W, int N, bf16* WT, int ldt, int k0, int n0, int drow0, LAS float* scr, int lane) {
    const int rr = lane >> 3, c4 = lane & 7;
    f32x4 v[8];
#pragma unroll
    for (int i = 0; i < 8; ++i) v[i] = *(const f32x4*)(W + (size_t)(k0 + 8 * i + rr) * N + n0 + 4 * c4);
#pragma unroll
    for (int i = 0; i < 8; ++i) { LAS float* sp = scr + (8 * i + rr) * 33 + 4 * c4; sp[0] = v[i].x; sp[1] = v[i].y; sp[2] = v[i].z; sp[3] = v[i].w; }
    LDS_WAIT(); asm volatile("" ::: "memory");
    const int c = lane & 7;
#pragma unroll
    for (int j = 0; j < 4; ++j) { const int n = (lane >> 3) + 8 * j; const LAS float* s = scr + (8 * c) * 33 + n;
        v4u o; o.x = pk2(s[0 * 33], s[1 * 33]); o.y = pk2(s[2 * 33], s[3 * 33]); o.z = pk2(s[4 * 33], s[5 * 33]); o.w = pk2(s[6 * 33], s[7 * 33]);
        *(GAS v4u*)(WT + (size_t)(drow0 + n) * ldt + k0 + 8 * c) = o; }
    LDS_WAIT(); asm volatile("" ::: "memory");
}

typedef float f32x16 __attribute__((ext_vector_type(16)));
typedef short s16x4 __attribute__((ext_vector_type(4)));
typedef unsigned v2u __attribute__((ext_vector_type(2)));
typedef __bf16 bf16x2_t __attribute__((ext_vector_type(2)));
typedef float f32x2_t __attribute__((ext_vector_type(2)));
#define MFMA32(a, b, c) __builtin_amdgcn_mfma_f32_32x32x16_bf16((a), (b), (c), 0, 0, 0)
__device__ __forceinline__ unsigned cvtpk_s(float lo, float hi) { f32x2_t v = {lo, hi}; bf16x2_t b = __builtin_convertvector(v, bf16x2_t); return __builtin_bit_cast(unsigned, b); }
constexpr float L2E = 1.4426950408889634f, NEG_BIG = -1e30f, RESC_THR = 8.0f;
constexpr int AT_STAGE = 36864, AT_VOFF = 16384;
constexpr int VC_A = 0, VC_B = MIXW, VC_S = 2 * MIXW, NVC = 2 * MIXW + SKV * HDIM;

__device__ __forceinline__ float xhalf_max(float x) { const unsigned u = __builtin_bit_cast(unsigned, x); auto r = __builtin_amdgcn_permlane32_swap(u, u, false, false); return fmaxf(__builtin_bit_cast(float, r[0]), __builtin_bit_cast(float, r[1])); }
__device__ __forceinline__ float xhalf_sum(float x) { const unsigned u = __builtin_bit_cast(unsigned, x); auto r = __builtin_amdgcn_permlane32_swap(u, u, false, false); return __builtin_bit_cast(float, r[0]) + __builtin_bit_cast(float, r[1]); }
template <int NK, int DV> struct StageRegs { v4u k[NK]; v4u v[DV / 64]; };
typedef short v4i16_t __attribute__((ext_vector_type(4)));
template <int NK, int DV>
__device__ __forceinline__ void at_load(StageRegs<NK, DV>& R, const bf16* QKV, int tok0, int kcol, int vcol, int tid) {
    const int row = tid >> 3, c = tid & 7; const bf16* rp = QKV + (size_t)(tok0 + row) * NQKV + 8 * c;
#pragma unroll
    for (int ki = 0; ki < NK; ++ki) R.k[ki] = *(const v4u*)(rp + kcol + 64 * ki);
#pragma unroll
    for (int vi = 0; vi < DV / 64; ++vi) R.v[vi] = *(const v4u*)(rp + vcol + 64 * vi);
}
template <int NK, int DV>
__device__ __forceinline__ void at_write(LAS unsigned char* buf, const StageRegs<NK, DV>& R, int tid) {
    const int row = tid >> 3, c = tid & 7;
#pragma unroll
    for (int ki = 0; ki < NK; ++ki) *(LAS v4u*)(buf + ki * 8192 + (row * 8 + (c ^ ((row >> 1) & 7))) * 16) = R.k[ki];
#pragma unroll
    for (int vi = 0; vi < DV / 64; ++vi) *(LAS v4u*)(buf + AT_VOFF + row * (2 * DV + 64) + (vi * 8 + c) * 16) = R.v[vi];
}
template <int DV>
__device__ __forceinline__ void at_lane_offsets(int lane, int& koff, int& voff) { const int r = lane & 31, hh = lane >> 5; koff = r * 128 + ((hh ^ ((r >> 1) & 7)) * 16);
    voff = (((lane & 15) >> 2) + 4 * hh) * (2 * DV + 64) + 32 * ((lane >> 4) & 1) + 8 * (lane & 3); }
template <int DV, int MODE>
__device__ __forceinline__ void at_compute(const LAS unsigned char* buf, int kidx, const bf16x8 (&Qf)[4], f32x16 (&Oa)[DV / 32], float& m, float& l, f32x16& negm, int lane, int koff, int voff, bool masked, int qpos, int kpos0, const float* bias) {
    const int hh = lane >> 5;
    f32x16 s0 = negm, s1 = negm;
    const LAS unsigned char* kb = buf + kidx * 8192;
#pragma unroll
    for (int ks = 0; ks < 4; ++ks) {
        const bf16x8 k0 = *(const LAS bf16x8*)(kb + (koff ^ (32 * ks)));
        const bf16x8 k1 = *(const LAS bf16x8*)(kb + 4096 + (koff ^ (32 * ks)));
        s0 = MFMA32(k0, Qf[ks], s0); s1 = MFMA32(k1, Qf[ks], s1); }
    if (MODE == 1) { if (masked) {
        int cs = qpos - NAC / 2; cs = cs < 0 ? 0 : (cs > GW - NAC ? GW - NAC : cs);
        const int vofs = 4 * hh - cs; const LAS unsigned char* tb = (const LAS unsigned char*)(size_t)0 + kpos0;
#pragma unroll
        for (int i = 0; i < 16; ++i) { const int c0 = (i & 3) + 8 * (i >> 2), c1 = c0 + 32;
            const float b0 = *(const LAS float*)(tb + 4 * c0), b1 = *(const LAS float*)(tb + 4 * c1);
            s0[i] = ((unsigned)(c0 + vofs) < (unsigned)NAC) ? s0[i] + b0 : NEG_BIG; s1[i] = ((unsigned)(c1 + vofs) < (unsigned)NAC) ? s1[i] + b1 : NEG_BIG; } } }
    if (MODE == 2) { if (masked) {
#pragma unroll
        for (int i = 0; i < 16; ++i) { const int d0 = kpos0 + (i & 3) + 8 * (i >> 2) + 4 * hh - qpos, d1 = d0 + 32;
            s0[i] = (d0 >= -SWW && d0 <= SWW) ? s0[i] : NEG_BIG; s1[i] = (d1 >= -SWW && d1 <= SWW) ? s1[i] : NEG_BIG; } } }
    const LAS unsigned char* vb = buf + AT_VOFF + voff;
    constexpr int VP = 2 * DV + 64;
#define AT_VTR(off) __builtin_bit_cast(s16x4, __builtin_amdgcn_ds_read_tr16_b64_v4i16((LAS v4i16_t*)(vb + (off))))
    s16x4 vlo[DV / 32], vhi[DV / 32];
#pragma unroll
    for (int b = 0; b < DV / 32; ++b) { vlo[b] = AT_VTR(64 * b); vhi[b] = AT_VTR(8 * VP + 64 * b); }
    __builtin_amdgcn_sched_barrier(0);
    float tmax = fmaxf(fmaxf(s0[0], s1[0]), s0[1]);
#pragma unroll
    for (int i = 1; i < 16; ++i) tmax = i == 1 ? fmaxf(tmax, s1[1]) : fmaxf(fmaxf(tmax, s0[i]), s1[i]);
    if (__any(tmax > RESC_THR)) {
        tmax = fmaxf(tmax, __shfl_xor(tmax, 32));
        const float d = fmaxf(tmax, 0.f), corr = __builtin_amdgcn_exp2f(-d);
        m += d; l *= corr;
#pragma unroll
        for (int b = 0; b < DV / 32; ++b) Oa[b] *= corr;
        s0 -= d; s1 -= d;
        const float nm = -m;
#pragma unroll
        for (int i = 0; i < 16; ++i) negm[i] = nm;
    }
#pragma unroll
    for (int i = 0; i < 16; ++i) { s0[i] = __builtin_amdgcn_exp2f(s0[i]); s1[i] = __builtin_amdgcn_exp2f(s1[i]); }
    { const f32x16 pp = s0 + s1; const f32x4 q4 = (f32x4){pp[0], pp[1], pp[2], pp[3]} + (f32x4){pp[4], pp[5], pp[6], pp[7]} + (f32x4){pp[8], pp[9], pp[10], pp[11]} + (f32x4){pp[12], pp[13], pp[14], pp[15]};
      l += (q4.x + q4.y) + (q4.z + q4.w); }
#pragma unroll
    for (int st = 0; st < 4; ++st) {
        const int sub = st >> 1, s = st & 1;
        u32x4 pk;
        if (sub == 0) { pk.x = cvtpk_s(s0[8 * s + 0], s0[8 * s + 1]); pk.y = cvtpk_s(s0[8 * s + 2], s0[8 * s + 3]); pk.z = cvtpk_s(s0[8 * s + 4], s0[8 * s + 5]); pk.w = cvtpk_s(s0[8 * s + 6], s0[8 * s + 7]); }
        else { pk.x = cvtpk_s(s1[8 * s + 0], s1[8 * s + 1]); pk.y = cvtpk_s(s1[8 * s + 2], s1[8 * s + 3]); pk.z = cvtpk_s(s1[8 * s + 4], s1[8 * s + 5]); pk.w = cvtpk_s(s1[8 * s + 6], s1[8 * s + 7]); }
        const bf16x8 pb = __builtin_bit_cast(bf16x8, pk);
        s16x4 nlo[DV / 32], nhi[DV / 32];
        if (st < 3) { const int k0 = 32 * ((st + 1) >> 1) + 16 * ((st + 1) & 1);
#pragma unroll
            for (int b = 0; b < DV / 32; ++b) { nlo[b] = AT_VTR(k0 * VP + 64 * b); nhi[b] = AT_VTR((k0 + 8) * VP + 64 * b); } }
        __builtin_amdgcn_sched_barrier(0);
#pragma unroll
        for (int b = 0; b < DV / 32; ++b) { const bf16x8 vf = __builtin_shufflevector(vlo[b], vhi[b], 0, 1, 2, 3, 4, 5, 6, 7); Oa[b] = MFMA32(vf, pb, Oa[b]); }
        if (st < 3) {
#pragma unroll
            for (int b = 0; b < DV / 32; ++b) { vlo[b] = nlo[b]; vhi[b] = nhi[b]; } }
    }
#undef AT_VTR
}
template <int DV>
__device__ __forceinline__ void at_store(bf16* orow, const f32x16 (&Oa)[DV / 32], float sc, int hh) {
#pragma unroll
    for (int b = 0; b < DV / 32; ++b)
#pragma unroll
        for (int g = 0; g < 4; ++g) { v2u o; o.x = cvtpk_s(Oa[b][4 * g] * sc, Oa[b][4 * g + 1] * sc); o.y = cvtpk_s(Oa[b][4 * g + 2] * sc, Oa[b][4 * g + 3] * sc);
            *(v2u*)(orow + 32 * b + 8 * g + 4 * hh) = o; }
}
__device__ __forceinline__ void at_loadq(bf16x8 (&Qf)[4], const bf16* qp, const float* gain, bool rope, int t, const F2* RT, int hh) {
    float x[4][8]; float ss = 0.f;
#pragma unroll
    for (int ks = 0; ks < 4; ++ks) { const v4u v = *(const v4u*)(qp + 16 * ks);
        x[ks][0] = bflo(v.x); x[ks][1] = bfhi(v.x); x[ks][2] = bflo(v.y); x[ks][3] = bfhi(v.y); x[ks][4] = bflo(v.z); x[ks][5] = bfhi(v.z); x[ks][6] = bflo(v.w); x[ks][7] = bfhi(v.w);
#pragma unroll
        for (int j = 0; j < 8; ++j) ss += x[ks][j] * x[ks][j]; }
    ss += __shfl_xor(ss, 32);
    const float r = 1.0f / sqrtf(ss * (1.f / 64.f) + NORM_EPS);
#pragma unroll
    for (int ks = 0; ks < 4; ++ks) { const f32x4 g0 = *(const f32x4*)(gain + 16 * ks + 8 * hh), g1 = *(const f32x4*)(gain + 16 * ks + 8 * hh + 4);
        x[ks][0] *= r * g0.x; x[ks][1] *= r * g0.y; x[ks][2] *= r * g0.z; x[ks][3] *= r * g0.w; x[ks][4] *= r * g1.x; x[ks][5] *= r * g1.y; x[ks][6] *= r * g1.z; x[ks][7] *= r * g1.w; }
    if (rope) {
#pragma unroll
        for (int p = 0; p < 2; ++p) { const int pos = p == 0 ? t / GW : t % GW;
#pragma unroll
            for (int j = 0; j < 8; ++j) { const F2 cs = RT[pos * 16 + 8 * hh + j]; const float a = x[2 * p][j], b2 = x[2 * p + 1][j];
                x[2 * p][j] = a * cs.x - b2 * cs.y; x[2 * p + 1][j] = b2 * cs.x + a * cs.y; } } }
    constexpr float QS = 0.125f * L2E;
#pragma unroll
    for (int ks = 0; ks < 4; ++ks) { u32x4 w; w.x = pk2(x[ks][0] * QS, x[ks][1] * QS); w.y = pk2(x[ks][2] * QS, x[ks][3] * QS); w.z = pk2(x[ks][4] * QS, x[ks][5] * QS); w.w = pk2(x[ks][6] * QS, x[ks][7] * QS);
        Qf[ks] = __builtin_bit_cast(bf16x8, w); }
}

template <bool CTXQ>
__device__ __forceinline__ void attn_diff_unit(LAS unsigned char* lds, const bf16* QKV, const bf16* VT, bf16* O, int b, int h, int qb, float lam, float lam_init, const float* subln, const float* qgain, const F2* RT, int tid, int wave, int lane) {
    asm volatile("" : "+v"(tid), "+v"(lane));
    int koff, voff; at_lane_offsets<128>(lane, koff, voff);
    const int r = lane & 31, hh = lane >> 5, qg = wave & 3, ih = wave >> 2;
    __builtin_amdgcn_sched_barrier(0);
    const int mq = (CTXQ ? M_LAT + b * CL : b * S) + qb * 128 + 32 * qg + r;
    bf16x8 Qf[4]; at_loadq(Qf, QKV + (size_t)mq * NQKV + C_BQ + 64 * (2 * h + ih) + 8 * hh, qgain, !CTXQ, qb * 128 + 32 * qg + r, RT, hh);
    f32x16 Oa[4];
#pragma unroll
    for (int bb = 0; bb < 4; ++bb)
#pragma unroll
        for (int i = 0; i < 16; ++i) Oa[bb][i] = 0.f;
    float m = 0.f, l = 0.f; f32x16 negm;
#pragma unroll
    for (int i = 0; i < 16; ++i) negm[i] = 0.f;
    constexpr int NLT = CTXQ ? 0 : S / 64, NT = NLT + CL / 64;
    const int kcol = C_BK + 128 * h, vcol = C_BV + 128 * h;
    StageRegs<2, 128> R;
    __syncthreads();
    at_load<2, 128>(R, QKV, NLT > 0 ? b * S : M_LAT + b * CL, kcol, vcol, tid);
    at_write<2, 128>(lds, R, tid);
    __syncthreads();
    for (int j = 0; j < NT; ++j) {
        if (j + 1 < NT) { const int jn = j + 1; at_load<2, 128>(R, QKV, jn < NLT ? b * S + 64 * jn : M_LAT + b * CL + 64 * (jn - NLT), kcol, vcol, tid); }
        at_compute<128, 0>(lds + (j & 1) * AT_STAGE, ih, Qf, Oa, m, l, negm, lane, koff, voff, false, 0, 0, nullptr);
        if (j + 1 < NT) at_write<2, 128>(lds + ((j + 1) & 1) * AT_STAGE, R, tid);
        __syncthreads();
    }
    const float lt = l + __shfl_xor(l, 32), inv = 1.0f / lt;
    LAS float* ex = (LAS float*)lds + (size_t)qg * 4096;
    if (ih == 1) {
#pragma unroll
        for (int bb = 0; bb < 4; ++bb)
#pragma unroll
            for (int i = 0; i < 16; ++i) ex[(bb * 16 + i) * 64 + lane] = Oa[bb][i] * inv * lam;
    }
    __syncthreads();
    if (ih == 0) {
        float ss = 0.f;
#pragma unroll
        for (int bb = 0; bb < 4; ++bb)
#pragma unroll
            for (int i = 0; i < 16; ++i) { const float v = Oa[bb][i] * inv - ex[(bb * 16 + i) * 64 + lane]; Oa[bb][i] = v; ss += v * v; }
        ss += __shfl_xor(ss, 32);
        const float rs = (1.0f / sqrtf(ss * (1.0f / 128.0f) + NORM_EPS)) * (1.0f - lam_init);
#pragma unroll
        for (int bb = 0; bb < 4; ++bb)
#pragma unroll
            for (int g = 0; g < 4; ++g) { const f32x4 sg = *(const f32x4*)(subln + 32 * bb + 8 * g + 4 * hh);
                Oa[bb][4 * g] *= sg.x; Oa[bb][4 * g + 1] *= sg.y; Oa[bb][4 * g + 2] *= sg.z; Oa[bb][4 * g + 3] *= sg.w; }
        at_store<128>(O + (size_t)mq * D + MIXW + 128 * h, Oa, rs, hh);
    }
}
template <bool CTXQ>
__device__ __forceinline__ void attn_swa_unit(LAS unsigned char* lds, const bf16* QKV, const bf16* VT, bf16* O, int b, int kvh, int qb, const float* sink, const float* qgain, const F2* RT, int tid, int wave, int lane) {
    asm volatile("" : "+v"(tid), "+v"(lane));
    int koff, voff; at_lane_offsets<64>(lane, koff, voff);
    const int r = lane & 31, hh = lane >> 5, qg = wave & 1, hq = kvh * SG + (wave >> 1);
    const int q0 = qb * 64, tq = q0 + 32 * qg + r;
    const int mq = (CTXQ ? M_LAT + b * CL : b * S) + tq;
    bf16x8 Qf[4]; at_loadq(Qf, QKV + (size_t)mq * NQKV + C_SQ + 64 * hq + 8 * hh, qgain, !CTXQ, tq, RT, hh);
    f32x16 Oa[2];
#pragma unroll
    for (int bb = 0; bb < 2; ++bb)
#pragma unroll
        for (int i = 0; i < 16; ++i) Oa[bb][i] = 0.f;
    float m = 0.f, l = 0.f; f32x16 negm;
#pragma unroll
    for (int i = 0; i < 16; ++i) negm[i] = 0.f;
    int jlo = 0, nlat = 0;
    if (!CTXQ) { jlo = q0 >= SWW ? 0 : (SWW - q0) / 64; int jhi = (S + SWW - q0) / 64; if (jhi > 5) jhi = 5; nlat = jhi - jlo; }
    const int NT = nlat + CL / 64;
    const int kcol = C_SK + 64 * kvh, vcol = C_SV + 64 * kvh;
    StageRegs<1, 64> R;
    __syncthreads();
    at_load<1, 64>(R, QKV, nlat > 0 ? b * S + q0 - SWW + 64 * jlo : M_LAT + b * CL, kcol, vcol, tid);
    at_write<1, 64>(lds, R, tid);
    __syncthreads();
    for (int j = 0; j < NT; ++j) {
        if (j + 1 < NT) { const int jn = j + 1; at_load<1, 64>(R, QKV, jn < nlat ? b * S + q0 - SWW + 64 * (jlo + jn) : M_LAT + b * CL + 64 * (jn - nlat), kcol, vcol, tid); }
        at_compute<64, 2>(lds + (j & 1) * AT_STAGE, 0, Qf, Oa, m, l, negm, lane, koff, voff, j < nlat && (jlo + j == 0 || jlo + j == 4), tq, q0 - SWW + 64 * (jlo + j), nullptr);
        if (j + 1 < NT) at_write<1, 64>(lds + ((j + 1) & 1) * AT_STAGE, R, tid);
        __syncthreads();
    }
    float lt = l + __shfl_xor(l, 32);
    const float sk = sink[hq] * L2E, mnew = fmaxf(m, sk), corr = __builtin_amdgcn_exp2f(m - mnew);
    lt = lt * corr + __builtin_amdgcn_exp2f(sk - mnew);
    at_store<64>(O + (size_t)mq * D + 2 * MIXW + 64 * hq, Oa, corr / lt, hh);
}
template <bool CTXQ>
__device__ __forceinline__ void attn_na_unit(LAS unsigned char* lds, const bf16* QKV, const bf16* VT, bf16* O, int b, int head, int rg, const float* rpb, const float* qgain, const F2* RT, int tid, int wave, int lane) {
    asm volatile("" : "+v"(tid), "+v"(lane));
    int koff, voff; at_lane_offsets<64>(lane, koff, voff);
    const int r = lane & 31, hh = lane >> 5, qg = wave & 1, gr = 4 * rg + (wave >> 1);
    const int qc = 32 * qg + r;
    const int mq = (CTXQ ? M_LAT + b * CL : b * S) + gr * GW + qc;
    bf16x8 Qf[4]; at_loadq(Qf, QKV + (size_t)mq * NQKV + C_AQ + 64 * head + 8 * hh, qgain, false, 0, RT, hh);
    f32x16 Oa[2];
#pragma unroll
    for (int bb = 0; bb < 2; ++bb)
#pragma unroll
        for (int i = 0; i < 16; ++i) Oa[bb][i] = 0.f;
    float m = 0.f, l = 0.f; f32x16 negm;
#pragma unroll
    for (int i = 0; i < 16; ++i) negm[i] = 0.f;
    int klo = 0, nlat = 0, rsw = 0;
    if (!CTXQ) { klo = 4 * rg - NAR / 2; klo = klo < 0 ? 0 : (klo > ROWS - NAR ? ROWS - NAR : klo); int kl3 = 4 * rg + 3 - NAR / 2; kl3 = kl3 < 0 ? 0 : (kl3 > ROWS - NAR ? ROWS - NAR : kl3); nlat = kl3 + NAR - klo;
        rsw = gr - NAR / 2; rsw = rsw < 0 ? 0 : (rsw > ROWS - NAR ? ROWS - NAR : rsw); }
    const int NT = nlat + CL / 64;
    const int kcol = C_AK + 64 * head, vcol = C_AV + 64 * head;
    StageRegs<1, 64> R;
    constexpr int NA_TBL = 73728, NA_TROW = 132;
    static_assert(2 * AT_STAGE <= NA_TBL && NA_TBL + (2 * NAR - 1) * NA_TROW * 4 <= RING_BYTES, "NA bias table");
    __syncthreads();
    if (!CTXQ) for (int i = tid; i < (2 * NAR - 1) * (2 * NAC - 1); i += NTHR) { const int dr_ = i / (2 * NAC - 1), ix_ = i - dr_ * (2 * NAC - 1);
        *(LAS float*)(lds + NA_TBL + (dr_ * NA_TROW + 48 + ix_) * 4) = rpb[head * (2 * NAR - 1) * (2 * NAC - 1) + i] * L2E; }
    const int btl = NA_TBL + (15 + 4 * hh - qc + 48) * 4;
    at_load<1, 64>(R, QKV, nlat > 0 ? b * S + klo * GW : M_LAT + b * CL, kcol, vcol, tid);
    at_write<1, 64>(lds, R, tid);
    __syncthreads();
    for (int j = 0; j < NT; ++j) {
        if (j + 1 < NT) { const int jn = j + 1; at_load<1, 64>(R, QKV, jn < nlat ? b * S + (klo + jn) * GW : M_LAT + b * CL + 64 * (jn - nlat), kcol, vcol, tid); }
        const int kr = klo + j; const bool lat = j < nlat;
        if (!lat || (kr >= rsw && kr < rsw + NAR))
            at_compute<64, 1>(lds + (j & 1) * AT_STAGE, 0, Qf, Oa, m, l, negm, lane, koff, voff, lat, qc, (int)(size_t)lds + btl + (kr - gr + NAR - 1) * NA_TROW * 4, nullptr);
        if (j + 1 < NT) at_write<1, 64>(lds + ((j + 1) & 1) * AT_STAGE, R, tid);
        __syncthreads();
    }
    const float lt = l + __shfl_xor(l, 32);
    at_store<64>(O + (size_t)mq * D + 64 * head, Oa, 1.0f / lt, hh);
}
__device__ __forceinline__ void vt_items4(LAS unsigned char* lds, const bf16* QKV, bf16* VT, int it0, int nit, int tid) {
    constexpr int NCT = NVC / 64;
    const int tok = tid >> 3, c8 = tid & 7;
    v4u v[4];
#pragma unroll
    for (int q = 0; q < 4; ++q) { const int it = it0 + q; v[q] = (v4u){0u, 0u, 0u, 0u};
        if (it < nit) { const int tt = it / NCT, ct = it % NCT; const int scol = ct < MIXW / 64 ? C_AV + 64 * ct : (ct < 2 * MIXW / 64 ? C_BV + 64 * (ct - MIXW / 64) : C_SV + 64 * (ct - 2 * MIXW / 64));
            v[q] = *(const v4u*)(QKV + (size_t)(tt * 64 + tok) * NQKV + scol + 8 * c8); } }
    __syncthreads();
#pragma unroll
    for (int q = 0; q < 4; ++q) { LAS unsigned short* T = (LAS unsigned short*)(lds + q * 9216) + (tok ^ (8 * c8));
        T[(8 * c8 + 0) * 72] = (unsigned short)(v[q].x & 0xffffu); T[(8 * c8 + 1) * 72] = (unsigned short)(v[q].x >> 16);
        T[(8 * c8 + 2) * 72] = (unsigned short)(v[q].y & 0xffffu); T[(8 * c8 + 3) * 72] = (unsigned short)(v[q].y >> 16);
        T[(8 * c8 + 4) * 72] = (unsigned short)(v[q].z & 0xffffu); T[(8 * c8 + 5) * 72] = (unsigned short)(v[q].z >> 16);
        T[(8 * c8 + 6) * 72] = (unsigned short)(v[q].w & 0xffffu); T[(8 * c8 + 7) * 72] = (unsigned short)(v[q].w >> 16); }
    __syncthreads();
    const int ch = tid >> 3, c = tid & 7;
#pragma unroll
    for (int q = 0; q < 4; ++q) { const int it = it0 + q;
        if (it < nit) { const int tt = it / NCT, ct = it % NCT;
            const v4u o = *(const LAS v4u*)(lds + q * 9216 + ch * 144 + ((c ^ (ch >> 3)) * 16));
            *(v4u*)(VT + (size_t)(ct * 64 + ch) * MT + tt * 64 + 8 * c) = o; } }
}
__device__ __forceinline__ void prep_geom(int gi, int& col0, int& ns) {
    if (gi == 0) { col0 = C_AQ; ns = NAH; } else if (gi == 1) { col0 = C_AK; ns = NAH; } else if (gi == 2) { col0 = C_BQ; ns = 2 * DFH; }
    else if (gi == 3) { col0 = C_BK; ns = 2 * DFH; } else if (gi == 4) { col0 = C_SQ; ns = SWH; } else { col0 = C_SK; ns = SKV; }
}
__device__ __forceinline__ v4u prep_load(const bf16* QKV, int m, int gi, int lane) {
    int col0, ns; prep_geom(gi, col0, ns);
    const int sl = lane >> 3, part = lane & 7;
    v4u v = (v4u){0u, 0u, 0u, 0u}; if (sl < ns) v = *(const v4u*)(QKV + (size_t)m * NQKV + col0 + 64 * sl + 8 * part);
    return v;
}
__device__ __forceinline__ void prep_finish(bf16* QKV, v4u v, int m, int gi, const LayerP& P, const F2* RT, int lane) {
    int col0, ns; prep_geom(gi, col0, ns);
    const float* g = gi == 0 ? P.aqn : gi == 1 ? P.akn : gi == 2 ? P.bqn : gi == 3 ? P.bkn : gi == 4 ? P.cqn : P.ckn;
    const bool isq = (gi == 0 || gi == 2 || gi == 4), rope = gi >= 2;
    const int sl = lane >> 3, part = lane & 7; const bool act = sl < ns;
    bool isctx; int b, t; row_decode(m, isctx, b, t);
    bf16* p = QKV + (size_t)m * NQKV + col0 + 64 * sl + 8 * part;
    float x[8] = {bflo(v.x), bfhi(v.x), bflo(v.y), bfhi(v.y), bflo(v.z), bfhi(v.z), bflo(v.w), bfhi(v.w)};
    float ss = 0.f;
#pragma unroll
    for (int i = 0; i < 8; ++i) ss += x[i] * x[i];
    ss += __shfl_xor(ss, 1); ss += __shfl_xor(ss, 2); ss += __shfl_xor(ss, 4);
    const float r = 1.0f / sqrtf(ss * (1.f / 64.f) + NORM_EPS);
    const f32x4 g0 = *(const f32x4*)(g + 8 * part), g1 = *(const f32x4*)(g + 8 * part + 4);
    x[0] *= r * g0.x; x[1] *= r * g0.y; x[2] *= r * g0.z; x[3] *= r * g0.w; x[4] *= r * g1.x; x[5] *= r * g1.y; x[6] *= r * g1.z; x[7] *= r * g1.w;
    if (rope && !isctx) {
        const int pos = (part >> 2) ? t % GW : t / GW; const bool hi = (part & 2) != 0; const int fb = 8 * (part & 1);
#pragma unroll
        for (int i = 0; i < 8; ++i) { const float o = __shfl_xor(x[i], 2); const F2 cs = RT[pos * 16 + fb + i]; x[i] = hi ? x[i] * cs.x + o * cs.y : x[i] * cs.x - o * cs.y; }
    }
    const float sc = isq ? 0.125f : 1.0f;
    v4u w; w.x = pk2(x[0] * sc, x[1] * sc); w.y = pk2(x[2] * sc, x[3] * sc); w.z = pk2(x[4] * sc, x[5] * sc); w.w = pk2(x[6] * sc, x[7] * sc);
    if (act) *(v4u*)p = w;
}
template <int W>
__device__ __forceinline__ void pool_d_w(const bf16* QKV, bf16* OUT, int ldo, int m, int c8) {
    bool isctx; int b, t; row_decode(m, isctx, b, t);
    const int T = isctx ? CL : S, ch = c8 * 8, lo = t - W / 2;
    const bf16* base = QKV + (size_t)(m - t) * NQKV + C_DU + ch;
    v4u v[W];
#pragma unroll
    for (int j = 0; j < W; ++j) { int jj = lo + j; jj = jj < 0 ? 0 : (jj > T - 1 ? T - 1 : jj); v[j] = *(const v4u*)(base + (size_t)jj * NQKV); }
    float sum[8] = {0.f, 0.f, 0.f, 0.f, 0.f, 0.f, 0.f, 0.f}; int cnt = 0;
#pragma unroll
    for (int j = 0; j < W; ++j) { const int jj = lo + j; const bool ok = jj >= 0 && jj < T; const float f = ok ? 1.0f : 0.0f; cnt += ok ? 1 : 0;
        sum[0] += f * bflo(v[j].x); sum[1] += f * bfhi(v[j].x); sum[2] += f * bflo(v[j].y); sum[3] += f * bfhi(v[j].y); sum[4] += f * bflo(v[j].z); sum[5] += f * bfhi(v[j].z); sum[6] += f * bflo(v[j].w); sum[7] += f * bfhi(v[j].w); }
    const float inv = 1.0f / (float)cnt; const v4u u = v[W / 2];
    v4u o; o.x = pk2(sum[0] * inv - bflo(u.x), sum[1] * inv - bfhi(u.x)); o.y = pk2(sum[2] * inv - bflo(u.y), sum[3] * inv - bfhi(u.y));
    o.z = pk2(sum[4] * inv - bflo(u.z), sum[5] * inv - bfhi(u.z)); o.w = pk2(sum[6] * inv - bflo(u.w), sum[7] * inv - bfhi(u.w));
    *(v4u*)(OUT + (size_t)m * ldo + ch) = o;
}
__device__ __forceinline__ int launder_i(int i) { asm volatile("" : "+s"(i)); return i; }
struct Args { const float* in[29]; float* out; unsigned char* ws; int ph_lo, ph_hi; };
static_assert(sizeof(Args) == 29 * 8 + 8 + 8 + 8, "Args has no padding");

enum { I_X = 0, I_C, I_CTX, I_CCTX, I_WADA, I_BADA, I_NMIX, I_NFFN, I_WIN, I_AQN, I_AKN, I_RPB, I_BQN, I_BKN, I_LQ1, I_LK1, I_LQ2, I_LK2, I_SUBLN, I_CQN, I_CKN, I_SINK, I_DW, I_DSCALE, I_WBR, I_WOUT, I_WG, I_WU, I_WD };
constexpr int NPRO = 2, NPL = 9, NPHASE = NPRO + NL * NPL;

__global__ void __launch_bounds__(NTHR, 2) mega(Args args) {
    extern __shared__ __attribute__((aligned(16))) unsigned char lds_raw[];
    LAS unsigned char* lds = (LAS unsigned char*)lds_raw;
    const int tid = threadIdx.x, lane0 = tid & 63, wave = __builtin_amdgcn_readfirstlane(tid >> 6);
    const int G = gridDim.x, bx = blockIdx.x;
    const int gw = bx * NWAVES + wave, NGW = G * NWAVES;
    const long gt0 = (long)bx * NTHR + tid, NGT = (long)G * NTHR;
    unsigned char* ws = args.ws;
    unsigned* ctl = (unsigned*)(ws + WS_CTL);
    float* CACT = (float*)(ws + WS_MISC + MISC_CACT); F2* RT = (F2*)(ws + WS_MISC + MISC_RT); float* LAM = (float*)(ws + WS_MISC + MISC_LAM); float* KG = (float*)(ws + WS_MISC + MISC_LAM + 64);
    float* MODV = (float*)(ws + WS_MODV); float* CTXR = (float*)(ws + WS_CTXR);
    bf16* WIN_T = (bf16*)(ws + WS_WIN);
    bf16* H = (bf16*)(ws + WS_H); float* OB = (float*)(ws + WS_H); bf16* QKV = (bf16*)(ws + WS_QKV); bf16* ACC = (bf16*)(ws + WS_QKV);
    unsigned char* GATES = ws + WS_GATES; bf16* HID = (bf16*)(ws + WS_GATES); bf16* DPOOL = (bf16*)(ws + WS_DPOOL); bf16* O = (bf16*)(ws + WS_O);
    u32x4* TMP = (u32x4*)(ws + WS_TMP) + (size_t)bx * (256 * 256 / 8); bf16* VT = (bf16*)(ws + WS_VT);
    bf16* XB = (bf16*)(ws + WS_XB); float* PB = (float*)(ws + WS_CTXR);

    for (int u = tid; u < (LDS_BYTES - LDSCTL_OFF) / 4; u += NTHR) ((LAS unsigned*)(lds + LDSCTL_OFF))[u] = 0u;
    __syncthreads();
    const int lo = args.ph_lo, hi = args.ph_hi;
    XcdBarrier bar; bar.bar = ctl + CW_BAR; bar.x = 0; bar.st = nullptr;
    if (hi - lo > 1) bar = xcd_barrier_post(ctl + CW_BAR, (volatile LAS unsigned*)(lds + MISC_OFF) + 8);
#define IN(k) (lo <= (k) && (k) < hi)
#define AIN(i) (args.in[launder_i(i)])
#define SEAM(k) do { if (IN(k) && IN((k) + 1)) xcd_barrier(bar); } while (0)

    constexpr int KS = 8, KSL = D / KS, NCB = 6 * D / 256;
    float* PART = (float*)(ws + WS_GATES);
    if (IN(0)) { long gt = gt0; asm volatile("" : "+v"(gt));
        for (long i = gt; i < 64 * 16; i += NGT) { const int pos = (int)(i / 16), f = (int)(i % 16); const float inv = powf(10000.0f, -(float)f / 16.0f); const float a = (float)pos * inv; F2 cs; cs.x = cosf(a); cs.y = sinf(a); RT[i] = cs; }
        for (long i = gt; i < NL * 64; i += NGT) { const int l_ = (int)(i / 64), e_ = (int)(i % 64); KG[l_ * 192 + e_] = AIN(I_AKN)[i]; KG[l_ * 192 + 64 + e_] = AIN(I_BKN)[i]; KG[l_ * 192 + 128 + e_] = AIN(I_CKN)[i]; }
        if (gt < NL) { const int l = (int)gt; float s1 = 0.f, s2 = 0.f;
            for (int i = 0; i < HDIM; ++i) { s1 += AIN(I_LQ1)[l * HDIM + i] * AIN(I_LK1)[l * HDIM + i]; s2 += AIN(I_LQ2)[l * HDIM + i] * AIN(I_LK2)[l * HDIM + i]; }
            const float li = 0.8f - 0.6f * expf(-0.3f * (float)l); LAM[2 * l] = expf(s1) - expf(s2) + li; LAM[2 * l + 1] = li; }
        int lane = lane0; asm volatile("" : "+v"(lane));
        static_assert(NCB % NWAVES == 0, "the 8 wave tasks of a workgroup share (layer, K slice)");
        LAS float* st = (LAS float*)lds;
        for (int t0 = bx * NWAVES; t0 < NL * KS * NCB; t0 += NGW) {
            const int cb = (t0 + wave) % NCB, ks = (t0 / NCB) % KS, l = t0 / (NCB * KS);
            __syncthreads();
            for (int i = tid; i < (NB + 1) * KSL; i += NTHR) { const int r = i / KSL, k = i - r * KSL; const float cv = r < NB ? AIN(I_C)[r * D + ks * KSL + k] : AIN(I_CCTX)[ks * KSL + k]; st[i] = cv / (1.0f + __expf(-cv)); }
            __syncthreads();
            const float* w = AIN(I_WADA) + ((size_t)l * D + (size_t)ks * KSL) * 6 * D + cb * 256 + 4 * lane;
            f32x4 a[NB + 1];
#pragma unroll
            for (int r = 0; r <= NB; ++r) a[r] = (f32x4){0.f, 0.f, 0.f, 0.f};
            f32x4 w0[4], w1[4];
#pragma unroll
            for (int i = 0; i < 4; ++i) w0[i] = *(const f32x4*)(w + (size_t)i * 6 * D);
#define ADA_ROWS(wv, kk) do { f32x4 ca = *(const LAS f32x4*)(st + (kk)); \
                _Pragma("unroll") for (int r = 0; r <= NB; ++r) { f32x4 na = ca; if (r < NB) na = *(const LAS f32x4*)(st + (r + 1) * KSL + (kk)); \
                    a[r] += wv[0] * ca.x; a[r] += wv[1] * ca.y; a[r] += wv[2] * ca.z; a[r] += wv[3] * ca.w; \
                    __builtin_amdgcn_sched_barrier(0); ca = na; } } while (0)
#pragma unroll 1
            for (int k = 0; k < KSL; k += 8) {
#pragma unroll
                for (int i = 0; i < 4; ++i) w1[i] = *(const f32x4*)(w + (size_t)(k + 4 + i) * 6 * D);
                ADA_ROWS(w0, k);
                if (k + 8 < KSL) {
#pragma unroll
                    for (int i = 0; i < 4; ++i) w0[i] = *(const f32x4*)(w + (size_t)(k + 8 + i) * 6 * D); }
                ADA_ROWS(w1, k + 4);
            }
#undef ADA_ROWS
#pragma unroll
            for (int r = 0; r <= NB; ++r) *(f32x4*)(PART + (((size_t)l * KS + ks) * (NB + 1) + r) * 6 * D + cb * 256 + 4 * lane) = a[r];
        }
    }
    SEAM(0);
    if (IN(1)) { long gt = gt0; asm volatile("" : "+v"(gt));
        for (long i = gt; i < (long)NL * (NB + 1) * (6 * D / 4); i += NGT) { const int j4 = (int)(i % (6 * D / 4)), r = (int)((i / (6 * D / 4)) % (NB + 1)), l = (int)(i / ((long)(6 * D / 4) * (NB + 1)));
            f32x4 s = *(const f32x4*)(AIN(I_BADA) + (size_t)l * 6 * D + 4 * j4);
#pragma unroll
            for (int ks = 0; ks < KS; ++ks) s += *(const f32x4*)(PART + (((size_t)l * KS + ks) * (NB + 1) + r) * 6 * D + 4 * j4);
            *(f32x4*)(MODV + ((size_t)l * (NB + 1) + r) * 6 * D + 4 * j4) = s; }
    }
    SEAM(1);
    for (int l = 0; l < NL; ++l) {
        const int pb = NPRO + l * NPL; const bool lastl = (l == NL - 1);
        const float* modl = MODV + (size_t)l * (NB + 1) * 6 * D;
#define XSRC() (l == 0 ? AIN(I_X) : (const float*)args.out)
#define CSRC() (l == 0 ? AIN(I_CTX) : (const float*)CTXR)

#define WOFS_ ((l & 1) ? (WS_W2 - WS_WBR) : (size_t)0)
#define WOFN_ ((l & 1) ? (size_t)0 : (WS_W2 - WS_WBR))
#define WBR_T ((bf16*)(ws + WS_WBR + WOFS_))
#define WOUT_T ((bf16*)(ws + WS_WOUT + WOFS_))
#define WGU_T ((bf16*)(ws + WS_WGU + WOFS_))
#define WD_T ((bf16*)(ws + WS_WD + WOFS_))
#define WBR_N ((bf16*)(ws + WS_WBR + WOFN_))
#define WOUT_N ((bf16*)(ws + WS_WOUT + WOFN_))
#define WGU_N ((bf16*)(ws + WS_WGU + WOFN_))
#define WD_N ((bf16*)(ws + WS_WD + WOFN_))
        constexpr int I_IN = (D / 64) * (PROJW / 32), I_BR = (MIXW / 64) * (D / 32), I_OUT = (D / 64) * (D / 32), I_GU = (D / 64) * (DFF / 32), I_DN = (DFF / 64) * (D / 32);
        constexpr int NIT = I_IN + 3 * I_BR + I_OUT + 2 * I_GU + I_DN;
#define CONV_ITEM(it_, LL, WBRp, WOUTp, WGUp, WDp) do { int r = (it_); \
            if (r < I_IN) { const int nb = PROJW / 32, kb = r / nb, n0 = (r % nb) * 32; transpose_item(AIN(I_WIN) + (size_t)(LL) * D * PROJW, PROJW, WIN_T, D, kb * 64, n0, kperm_row(n0), scr, lane); break; } r -= I_IN; \
            if (r < 3 * I_BR) { const int n = r / I_BR, rr = r % I_BR, nb = D / 32, kb = rr / nb, n0 = (rr % nb) * 32; \
                transpose_item(AIN(I_WBR) + ((size_t)(LL) * 4 + n) * MIXW * D, D, (WBRp) + (size_t)n * D * MIXW, MIXW, kb * 64, n0, n0, scr, lane); break; } r -= 3 * I_BR; \
            if (r < I_OUT) { const int nb = D / 32, kb = r / nb, n0 = (r % nb) * 32; transpose_item(AIN(I_WOUT) + (size_t)(LL) * D * D, D, (WOUTp), D, kb * 64, n0, n0, scr, lane); break; } r -= I_OUT; \
            if (r < 2 * I_GU) { const int up = r / I_GU, rr = r % I_GU, nb = DFF / 32, kb = rr / nb, n0 = (rr % nb) * 32; \
                transpose_item(AIN(up ? I_WU : I_WG) + (size_t)(LL) * D * DFF, DFF, (WGUp), D, kb * 64, n0, (n0 / 128) * 256 + (n0 % 128) + up * 128, scr, lane); break; } r -= 2 * I_GU; \
            { const int nb = D / 32, kb = r / nb, n0 = (r % nb) * 32; transpose_item(AIN(I_WD) + (size_t)(LL) * DFF * D, D, (WDp), DFF, kb * 64, n0, n0, scr, lane); } } while (0)
#define POOL_FOLD(LL, WBRp) do { \
            for (int task = gw; task < (MIXW / 8) * (D / 64); task += NGW) { \
                const int kc8 = task % (MIXW / 8), db = task / (MIXW / 8), k0 = kc8 * 8, g = k0 / PGW, c0 = k0 % PGW, d = db * 64 + lane; \
                const float* dw = AIN(I_DW) + (size_t)(LL) * 4 * PGW * PGW + ((size_t)g * PGW + c0) * PGW; \
                const float* dsc = AIN(I_DSCALE) + (LL) * MIXW + g * PGW; \
                const float* wb = AIN(I_WBR) + ((size_t)(LL) * 4 + 3) * MIXW * D + (size_t)(g * PGW) * D + d; \
                float a[8]; \
                _Pragma("unroll") for (int i = 0; i < 8; ++i) a[i] = 0.f; \
                _Pragma("unroll 1") for (int e0 = 0; e0 < PGW; e0 += 16) { float wv[16];                         \
                    _Pragma("unroll") for (int e = 0; e < 16; ++e) wv[e] = wb[(size_t)(e0 + e) * D]; \
                    _Pragma("unroll") for (int e = 0; e < 16; ++e) { const float ws_ = wv[e] * dsc[e0 + e]; \
                        _Pragma("unroll") for (int i = 0; i < 8; ++i) a[i] += dw[i * PGW + e0 + e] * ws_; } } \
                v4u o; o.x = pk2(a[0], a[1]); o.y = pk2(a[2], a[3]); o.z = pk2(a[4], a[5]); o.w = pk2(a[6], a[7]); \
                *(v4u*)((WBRp) + (size_t)3 * D * MIXW + (size_t)d * MIXW + k0) = o; } } while (0)

        if (IN(pb + 0) && l == 0) {
            int lane = lane0; asm volatile("" : "+v"(lane));
            LAS float* scr = (LAS float*)(lds + wave * 16384);
            for (int it = gw; it < NIT; it += NGW) CONV_ITEM(it, 0, WBR_T, WOUT_T, WGU_T, WD_T);
            POOL_FOLD(0, WBR_T);
        }
#define NORM_PHASE_F(nrows, gainp, CH_SH, CH_SC, srcl, srcc) do { int lane = lane0; asm volatile("" : "+v"(lane)); \
            for (int p = gw; p < (nrows) / 2; p += NGW) { const int m = 2 * p; const bool isc = m >= M_LAT;        \
                const float* xr = isc ? (srcc) + (size_t)(m - M_LAT) * D : (srcl) + (size_t)m * D; \
                const float* mr = modl + (size_t)(isc ? NB : m / S) * 6 * D; \
                f32x4 v[2][D / 256]; float ss0 = 0.f, ss1 = 0.f; \
                _Pragma("unroll") for (int j = 0; j < D / 256; ++j) { v[0][j] = *(const f32x4*)(xr + 4 * lane + 256 * j); v[1][j] = *(const f32x4*)(xr + D + 4 * lane + 256 * j); } \
                _Pragma("unroll") for (int j = 0; j < D / 256; ++j) { ss0 += (v[0][j].x * v[0][j].x + v[0][j].y * v[0][j].y) + (v[0][j].z * v[0][j].z + v[0][j].w * v[0][j].w); \
                    ss1 += (v[1][j].x * v[1][j].x + v[1][j].y * v[1][j].y) + (v[1][j].z * v[1][j].z + v[1][j].w * v[1][j].w); } \
                const float rs0 = 1.0f / sqrtf(wave_sum(ss0) * (1.0f / D) + NORM_EPS), rs1 = 1.0f / sqrtf(wave_sum(ss1) * (1.0f / D) + NORM_EPS); \
                _Pragma("unroll") for (int j = 0; j < D / 256; ++j) { const int c = 4 * lane + 256 * j; \
                    const f32x4 gn = *(const f32x4*)((gainp) + c), sh = *(const f32x4*)(mr + (CH_SH) * D + c), sc = *(const f32x4*)(mr + (CH_SC) * D + c); \
                    const f32x4 mg = gn * (sc + 1.0f); \
                    f32x4 y = (v[0][j] * rs0) * mg + sh; \
                    unsigned long long o = (unsigned long long)pk2(y.x, y.y) | ((unsigned long long)pk2(y.z, y.w) << 32); \
                    *(unsigned long long*)(H + (size_t)m * D + c) = o; \
                    y = (v[1][j] * rs1) * mg + sh; \
                    o = (unsigned long long)pk2(y.x, y.y) | ((unsigned long long)pk2(y.z, y.w) << 32); \
                    *(unsigned long long*)(H + (size_t)(m + 1) * D + c) = o; \
                    unsigned long long xo = (unsigned long long)pk2(v[0][j].x, v[0][j].y) | ((unsigned long long)pk2(v[0][j].z, v[0][j].w) << 32); \
                    *(unsigned long long*)(XB + (size_t)m * D + c) = xo; \
                    xo = (unsigned long long)pk2(v[1][j].x, v[1][j].y) | ((unsigned long long)pk2(v[1][j].z, v[1][j].w) << 32); \
                    *(unsigned long long*)(XB + (size_t)(m + 1) * D + c) = xo; } } } while (0)
#define NORM_UNP(u, x0, x1) do { x0.x = bflo(u.x); x0.y = bfhi(u.x); x0.z = bflo(u.y); x0.w = bfhi(u.y); x1.x = bflo(u.z); x1.y = bfhi(u.z); x1.z = bflo(u.w); x1.w = bfhi(u.w); } while (0)
#define NORM_PHASE_B(nrows, gainp, CH_SH, CH_SC) do { int lane = lane0; asm volatile("" : "+v"(lane)); \
            for (int p = gw; p < (nrows) / 2; p += NGW) { const int m = 2 * p; const bool isc = m >= M_LAT;        \
                const bf16* xr = XB + (size_t)m * D; \
                const float* mr = modl + (size_t)(isc ? NB : m / S) * 6 * D; \
                u32x4 v[2][D / 512]; float ss0 = 0.f, ss1 = 0.f; \
                _Pragma("unroll") for (int j = 0; j < D / 512; ++j) { v[0][j] = *(const u32x4*)(xr + 8 * lane + 512 * j); v[1][j] = *(const u32x4*)(xr + D + 8 * lane + 512 * j); } \
                if (isc) { const float* pr = PB + (size_t)(m - M_LAT) * D + 8 * lane;        \
                    _Pragma("unroll") for (int j = 0; j < D / 512; ++j) _Pragma("unroll") for (int r_ = 0; r_ < 2; ++r_) { \
                        const f32x4 p0 = *(const f32x4*)(pr + (size_t)r_ * D + 512 * j), p1 = *(const f32x4*)(pr + (size_t)r_ * D + 512 * j + 4); \
                        f32x4 x0, x1; NORM_UNP(v[r_][j], x0, x1); x0 += p0; x1 += p1; \
                        u32x4 o; o.x = pk2(x0.x, x0.y); o.y = pk2(x0.z, x0.w); o.z = pk2(x1.x, x1.y); o.w = pk2(x1.z, x1.w); v[r_][j] = o; \
                        *(u32x4*)(XB + (size_t)(m + r_) * D + 8 * lane + 512 * j) = o; } } \
                _Pragma("unroll") for (int j = 0; j < D / 512; ++j) { f32x4 x0, x1; NORM_UNP(v[0][j], x0, x1); \
                    ss0 += ((x0.x * x0.x + x0.y * x0.y) + (x0.z * x0.z + x0.w * x0.w)) + ((x1.x * x1.x + x1.y * x1.y) + (x1.z * x1.z + x1.w * x1.w)); \
                    NORM_UNP(v[1][j], x0, x1); \
                    ss1 += ((x0.x * x0.x + x0.y * x0.y) + (x0.z * x0.z + x0.w * x0.w)) + ((x1.x * x1.x + x1.y * x1.y) + (x1.z * x1.z + x1.w * x1.w)); } \
                const float rs0 = 1.0f / sqrtf(wave_sum(ss0) * (1.0f / D) + NORM_EPS), rs1 = 1.0f / sqrtf(wave_sum(ss1) * (1.0f / D) + NORM_EPS); \
                _Pragma("unroll") for (int j = 0; j < D / 512; ++j) { const int c = 8 * lane + 512 * j; \
                    const f32x4 gn0 = *(const f32x4*)((gainp) + c), sh0 = *(const f32x4*)(mr + (CH_SH) * D + c), sc0 = *(const f32x4*)(mr + (CH_SC) * D + c); \
                    const f32x4 gn1 = *(const f32x4*)((gainp) + c + 4), sh1 = *(const f32x4*)(mr + (CH_SH) * D + c + 4), sc1 = *(const f32x4*)(mr + (CH_SC) * D + c + 4); \
                    const f32x4 m0 = gn0 * (sc0 + 1.0f), m1 = gn1 * (sc1 + 1.0f); \
                    f32x4 x0, x1; NORM_UNP(v[0][j], x0, x1); \
                    f32x4 y0 = (x0 * rs0) * m0 + sh0, y1 = (x1 * rs0) * m1 + sh1; \
                    u32x4 o; o.x = pk2(y0.x, y0.y); o.y = pk2(y0.z, y0.w); o.z = pk2(y1.x, y1.y); o.w = pk2(y1.z, y1.w); \
                    *(u32x4*)(H + (size_t)m * D + c) = o; \
                    NORM_UNP(v[1][j], x0, x1); \
                    y0 = (x0 * rs1) * m0 + sh0; y1 = (x1 * rs1) * m1 + sh1; \
                    o.x = pk2(y0.x, y0.y); o.y = pk2(y0.z, y0.w); o.z = pk2(y1.x, y1.y); o.w = pk2(y1.z, y1.w); \
                    *(u32x4*)(H + (size_t)(m + 1) * D + c) = o; } } } while (0)
        if (IN(pb + 0)) { if (l == 0) { const float* xs_ = AIN(I_X); const float* cs_ = AIN(I_CTX); NORM_PHASE_F(MT, AIN(I_NMIX) + (size_t)l * D, 0, 1, xs_, cs_); }
                          else NORM_PHASE_B(MT, AIN(I_NMIX) + (size_t)l * D, 0, 1); }
        SEAM(pb + 0);

        if (IN(pb + 1)) {
            pg8::Gemm g{H, WIN_T, D, D, D};
            pg8::Sched Sd{M_LAT / 256, PROJW / 256, M_CTX / 256, lastl ? NQKV / 256 : PROJW / 256, 1, G, bx, 0, 0, 0, 0};
            EpiWin E{QKV, GATES, KG + l * 192, RT};
            pg8::gemm_phase<EpiWin>(lds, g, Sd, E);
        }
        SEAM(pb + 1);

#define MAKE_P() LayerP P; P.aqn = AIN(I_AQN) + l * HDIM; P.akn = AIN(I_AKN) + l * HDIM; P.rpb = AIN(I_RPB) + (size_t)l * NAH * (2 * NAR - 1) * (2 * NAC - 1); \
        P.bqn = AIN(I_BQN) + l * HDIM; P.bkn = AIN(I_BKN) + l * HDIM; P.subln = AIN(I_SUBLN) + l * 128; P.cqn = AIN(I_CQN) + l * HDIM; P.ckn = AIN(I_CKN) + l * HDIM; \
        P.sink = AIN(I_SINK) + l * SWH; P.dw = AIN(I_DW) + (size_t)l * 4 * PGW * PGW; P.dscale = AIN(I_DSCALE) + l * MIXW

        if (IN(pb + 3)) {
            MAKE_P();
            int tidl = tid; asm volatile("" : "+v"(tidl));
#define lanel (tidl & 63)
            const float lam = LAM[2 * l], lami = LAM[2 * l + 1];
            constexpr int U_DIFF = NB * DFH * (S / 128), U_NA = NB * NAH * (ROWS / 4), U_SWA = NB * SKV * (S / 64);
            constexpr int U_DIFFC = NB * DFH * (CL / 128), U_NAC = NB * NAH * (CL / 256), U_SWAC = NB * SKV * (CL / 64);
            static_assert(U_DIFF % 8 == 0 && U_NA % 8 == 0 && U_SWA % 8 == 0 && U_DIFFC % 8 == 0 && U_NAC % 8 == 0 && U_SWAC % 8 == 0, "unit counts");
            const int utot = U_DIFF + U_NA + U_SWA + (lastl ? 0 : U_DIFFC + U_NAC + U_SWAC);
            #define XREM(v, n) (((v) % 8) * ((n) / 8) + (v) / 8)
            for (int u = bx; u < U_DIFF; u += G) { int v = u; if (v < U_DIFF) { v = XREM(v, U_DIFF); const int qb = v % (S / 128), h = (v / (S / 128)) % DFH, b = v / ((S / 128) * DFH); attn_diff_unit<false>(lds, QKV, VT, O, b, h, qb, lam, lami, P.subln, P.bqn, RT, tidl, wave, lanel); continue; } v -= U_DIFF; }
            if (!lastl) for (int u = bx; u < U_DIFFC; u += G) { int v = u; if (v < U_DIFFC) { v = XREM(v, U_DIFFC); const int qb = v % (CL / 128), h = (v / (CL / 128)) % DFH, b = v / ((CL / 128) * DFH); attn_diff_unit<true>(lds, QKV, VT, O, b, h, qb, lam, lami, P.subln, P.bqn, RT, tidl, wave, lanel); continue; } v -= U_DIFFC; }
#define CONV_STEPS(uc_) ((uc_) < 8 ? 2 * (uc_) : (uc_) + 8)
            const int utot2 = U_NA + U_SWA + (lastl ? 0 : U_NAC + U_SWAC);
            for (int u = bx; u < utot2; u += G) {
                if (!lastl) {
                    const int uc = (u - bx) / G; int cit = gw + CONV_STEPS(uc) * NGW; const int cend = gw + CONV_STEPS(uc + 1) * NGW;
                    if (cit < NIT) {
                        int lane = lanel; LAS float* scr = (LAS float*)(lds + wave * 16384);
                        __syncthreads();
                        for (; cit < cend && cit < NIT; cit += NGW) CONV_ITEM(cit, l + 1, WBR_N, WOUT_N, WGU_N, WD_N);
                    }
                }
                int v = u;
                if (v < U_NA) { v = XREM(v, U_NA); const int rg = v % (ROWS / 4), hd = (v / (ROWS / 4)) % NAH, b = v / ((ROWS / 4) * NAH); attn_na_unit<false>(lds, QKV, VT, O, b, hd, rg, P.rpb, P.aqn, RT, tidl, wave, lanel); continue; } v -= U_NA;
                if (v < U_SWA) { v = XREM(v, U_SWA); const int qb = v % (S / 64), kvh = (v / (S / 64)) % SKV, b = v / ((S / 64) * SKV); attn_swa_unit<false>(lds, QKV, VT, O, b, kvh, qb, P.sink, P.cqn, RT, tidl, wave, lanel); continue; } v -= U_SWA;
                if (v < U_NAC) { v = XREM(v, U_NAC); const int rg = v % (CL / 256), hd = (v / (CL / 256)) % NAH, b = v / ((CL / 256) * NAH); attn_na_unit<true>(lds, QKV, VT, O, b, hd, rg, P.rpb, P.aqn, RT, tidl, wave, lanel); continue; } v -= U_NAC;
                { v = XREM(v, U_SWAC); const int qb = v % (CL / 64), kvh = (v / (CL / 64)) % SKV, b = v / ((CL / 64) * SKV); attn_swa_unit<true>(lds, QKV, VT, O, b, kvh, qb, P.sink, P.cqn, RT, tidl, wave, lanel); }
            }
            if (!lastl) {
                int lane = lanel; LAS float* scr = (LAS float*)(lds + wave * 16384);
                __syncthreads();
                static_assert(CONV_STEPS((U_NA + U_SWA + U_NAC + U_SWAC) / 256) * 2048 >= NIT, "every workgroup's in-loop conversion steps cover all items (256 workgroups x 8 waves)");
                POOL_FOLD(l + 1, WBR_N);
            }
            {
                const int pm_rows = lastl ? M_LAT : MT; long gt = gt0; asm volatile("" : "+v"(gt));
                for (long i = gt; i < (long)pm_rows * 16; i += NGT) { const int m = (int)(i >> 4), cl = (int)(i & 15);
                    pool_d_w<2>(QKV, O + 3 * MIXW, D, m, cl); pool_d_w<4>(QKV, O + 3 * MIXW, D, m, 16 + cl); pool_d_w<8>(QKV, O + 3 * MIXW, D, m, 32 + cl); pool_d_w<16>(QKV, O + 3 * MIXW, D, m, 48 + cl); } }
        }
#undef lanel
        SEAM(pb + 3);

        if (IN(pb + 4)) {
            pg8::merge_phase(lds, O, WBR_T, GATES, ACC, lastl ? M_LAT / 256 : MT / 256, G, bx);
        }
        SEAM(pb + 4);

        if (IN(pb + 5)) {
            pg8::Gemm g{ACC, WOUT_T, D, D, D};
            pg8::Sched Sd{M_LAT / 256, D / 256, lastl ? 0 : M_CTX / 256, D / 256, 1, G, bx, (size_t)(D / 2), D / 2, 0, 1};
            EpiResid E{XB, nullptr, PB, modl, 2};
            pg8::gemm_phase<EpiResid>(lds, g, Sd, E);
        }
        SEAM(pb + 5);

        if (IN(pb + 6)) { const int nr = lastl ? M_LAT : MT; NORM_PHASE_B(nr, AIN(I_NFFN) + (size_t)l * D, 3, 4); }
        SEAM(pb + 6);

        if (IN(pb + 7)) {
            pg8::Gemm g{H, WGU_T, D, D, D};
            pg8::Sched Sd{M_LAT / 256, 2 * DFF / 256, lastl ? 0 : M_CTX / 256, 2 * DFF / 256, 1, G, bx, 0, 0, 0, 0};
            EpiFfnUp E{HID};
            pg8::gemm_phase<EpiFfnUp>(lds, g, Sd, E);
        }
        SEAM(pb + 7);

        if (IN(pb + 8)) {
            pg8::Gemm g{HID, WD_T, DFF, DFF, DFF};
            pg8::Sched Sd{M_LAT / 256, D / 256, lastl ? 0 : M_CTX / 256, D / 256, 1, G, bx, (size_t)(DFF / 2), DFF / 2, 1, 1};
            EpiResid E{XB, lastl ? args.out : nullptr, PB, modl, 5};
            pg8::gemm_phase<EpiResid>(lds, g, Sd, E);
        }
        SEAM(pb + 8);
    }
#undef IN
#undef SEAM
#undef AIN
#undef XSRC
#undef CSRC
#undef NORM_PHASE_F
#undef CONV_ITEM
#undef WOFS_
#undef WOFN_
#undef WBR_T
#undef WOUT_T
#undef WGU_T
#undef WD_T
#undef WBR_N
#undef WOUT_N
#undef WGU_N
#undef WD_N
#undef CONV_STEPS
#undef POOL_FOLD
#undef NORM_PHASE_B
#undef NORM_UNP
#undef MAKE_P
}

#ifndef MK_PER_PHASE
#define MK_PER_PHASE 0
#endif
extern "C" void kernel_launch(void* const* d_in, const int* in_sizes, int n_in, void* d_out, int out_size, void* d_ws, size_t ws_size, hipStream_t stream) {
    static int grid = 0;
    if (grid == 0) {
        if (n_in != 29 || out_size != M_LAT * D || ws_size < WS_END) { fprintf(stderr, "kernel_launch: unexpected shapes (n_in %d out %d ws %zu need %zu)\n", n_in, out_size, ws_size, (size_t)WS_END); grid = -1; return; }
        int dev = 0, cus = 0, per_cu = 0;
        if (hipGetDevice(&dev) != hipSuccess || hipDeviceGetAttribute(&cus, hipDeviceAttributeMultiprocessorCount, dev) != hipSuccess) { grid = -1; return; }
        if (hipFuncSetAttribute((const void*)mega, hipFuncAttributeMaxDynamicSharedMemorySize, LDS_BYTES) != hipSuccess) { fprintf(stderr, "kernel_launch: hipFuncSetAttribute failed\n"); grid = -1; return; }
        if (hipOccupancyMaxActiveBlocksPerMultiprocessor(&per_cu, (const void*)mega, NTHR, LDS_BYTES) != hipSuccess || per_cu < 1) fprintf(stderr, "kernel_launch: occupancy query reports %d\n", per_cu);
        (void)hipGetLastError();
        grid = cus > 256 ? 256 : cus;
    }
    if (grid < 0) return;
    if (hipMemsetAsync((char*)d_ws + WS_CTL, 0, CTL_ZERO_BYTES, stream) != hipSuccess) return;
    Args a{};
    for (int i = 0; i < 29; ++i) a.in[i] = (const float*)d_in[i];
    a.out = (float*)d_out; a.ws = (unsigned char*)d_ws;
#if MK_PER_PHASE
    for (int p = 0; p < NPHASE; ++p) { a.ph_lo = p; a.ph_hi = p + 1;
        hipLaunchKernelGGL(mega, dim3(grid), dim3(NTHR), LDS_BYTES, stream, a); }
#else
    a.ph_lo = 0; a.ph_hi = NPHASE; hipLaunchKernelGGL(mega, dim3(grid), dim3(NTHR), LDS_BYTES, stream, a);
#endif
}
#endif
```
